# Optimizing an MI355X kernel written in HIP

```python
import jax, jax.numpy as jnp
from jax import lax
import numpy as np

D_MODEL = 1024
BATCH = 4
SEQ = 8192
DEPTH = 1

D_MIX = D_MODEL
D_POOL = D_MIX // 2
D_MLSTM = D_MIX - D_POOL
POOL_WINDOWS = (2, 4, 8, 16)
N_POOL_GROUPS = len(POOL_WINDOWS)
POOL_GROUP_DIM = D_POOL // N_POOL_GROUPS
N_HEADS = 4
HEAD_DIM = D_MLSTM // N_HEADS
CONV_WIDTH = 4
CHUNK = 128
EPS = 1e-6
OFF_U = 0
OFF_ZP = OFF_U + D_POOL
OFF_Q = OFF_ZP + D_POOL
OFF_K = OFF_Q + D_MLSTM
OFF_V = OFF_K + D_MLSTM
OFF_O = OFF_V + D_MLSTM
OFF_ZM = OFF_O + D_MLSTM
OFF_G = OFF_ZM + D_MLSTM
D_IN_PROJ = OFF_G + 2 * N_HEADS

kernel_name = "hymba_pool_mlstm_adaln_block"


def rms_norm(x, g):
    xf = x.astype(jnp.float32)
    y = xf * lax.rsqrt(jnp.mean(xf * xf, axis=-1, keepdims=True) + EPS)
    return (y * g.astype(jnp.float32)).astype(x.dtype)


def causal_pool_mixer(u, w_pool, ls_pool):
    B, S, _ = u.shape
    ug = u.astype(jnp.float32).reshape(B, S, N_POOL_GROUPS, POOL_GROUP_DIM)
    cs = jnp.cumsum(ug, axis=1)
    pos = jnp.arange(1, S + 1, dtype=jnp.float32)
    outs = []
    for g, w in enumerate(POOL_WINDOWS):
        c_g = cs[:, :, g]
        lag = jnp.pad(c_g[:, :S - w], ((0, 0), (w, 0), (0, 0)))
        mean = (c_g - lag) / jnp.minimum(pos, float(w))[None, :, None]
        outs.append(mean - ug[:, :, g])
    pooled = jnp.stack(outs, axis=2)
    y = jnp.einsum('bsgc,gcd->bsgd', pooled, w_pool.astype(jnp.float32))
    y = y.reshape(B, S, D_POOL) * ls_pool.astype(jnp.float32)
    return y.astype(u.dtype)


def causal_depthwise_conv(x, w, b):
    S = x.shape[1]
    xp = jnp.pad(x, ((0, 0), (CONV_WIDTH - 1, 0), (0, 0)))
    y = b
    for j in range(CONV_WIDTH):
        y = y + w[j] * xp[:, j:j + S]
    return y


def _mlstm_chunk_step(carry, inp):
    C, n, m = carry
    q, k, v, ig, lf = inp
    L = q.shape[2]
    b = jnp.cumsum(lf, axis=-1)
    causal = jnp.tril(jnp.ones((L, L), dtype=bool))
    d_log = jnp.where(causal, b[..., :, None] - b[..., None, :] + ig[..., None, :], -jnp.inf)
    inter_log = b + m[..., None]
    m_t = jnp.maximum(inter_log, jnp.max(d_log, axis=-1))
    dmat = jnp.exp(d_log - m_t[..., None])
    inter = jnp.exp(inter_log - m_t)
    s = jnp.einsum('bhtd,bhsd->bhts', q, k) * dmat
    num = jnp.einsum('bhts,bhsd->bhtd', s, v) + inter[..., None] * jnp.einsum('bhvd,bhtd->bhtv', C, q)
    den = jnp.sum(s, axis=-1) + inter * jnp.einsum('bhd,bhtd->bht', n, q)
    h = num / jnp.maximum(jnp.abs(den), jnp.exp(-m_t))[..., None]
    b_last = b[..., -1]
    w_log = b_last[..., None] - b + ig
    m_new = jnp.maximum(b_last + m, jnp.max(w_log, axis=-1))
    w = jnp.exp(w_log - m_new[..., None])
    decay = jnp.exp(b_last + m - m_new)
    C_new = decay[..., None, None] * C + jnp.einsum('bhs,bhsv,bhsd->bhvd', w, v, k)
    n_new = decay[..., None] * n + jnp.einsum('bhs,bhsd->bhd', w, k)
    return (C_new, n_new, m_new), h


def _to_chunks(a):
    B, S = a.shape[:2]
    a = a.reshape((B, S // CHUNK, CHUNK) + a.shape[2:])
    return jnp.swapaxes(jnp.moveaxis(a, 1, 0), 2, 3)


def mlstm_chunkwise(q, k, v, ig, lf):
    B, S, H, dh = q.shape
    f32 = jnp.float32
    k = k / jnp.sqrt(jnp.asarray(dh, f32)).astype(k.dtype)
    xs = tuple(_to_chunks(a.astype(f32)) for a in (q, k, v, ig, lf))
    carry0 = (jnp.zeros((B, H, dh, dh), f32), jnp.zeros((B, H, dh), f32), jnp.zeros((B, H), f32))
    _, hs = lax.scan(_mlstm_chunk_step, carry0, xs)
    hs = jnp.moveaxis(jnp.swapaxes(hs, 2, 3), 0, 1)
    return hs.reshape(B, S, H, dh)


def setup_inputs(seed: int = 0) -> dict:
    key = jax.random.key(seed)
    ks = jax.random.split(key, 16)
    nrm = jax.random.normal
    f32 = jnp.float32
    x = nrm(ks[0], (BATCH, SEQ, D_MODEL), f32)
    c = nrm(ks[1], (BATCH, D_MODEL), f32)
    norm_g = 1.0 + 0.02 * nrm(ks[2], (DEPTH, D_MODEL), f32)
    w_ada = 0.5 * D_MODEL ** -0.5 * nrm(ks[3], (DEPTH, D_MODEL, 3 * D_MODEL), f32)
    b_ada = 0.01 * nrm(ks[4], (DEPTH, 3 * D_MODEL), f32)
    w_in = D_MODEL ** -0.5 * nrm(ks[5], (DEPTH, D_MODEL, D_IN_PROJ), f32)
    b_igate = 0.1 * nrm(ks[6], (DEPTH, N_HEADS), f32)
    b_fgate = jnp.linspace(3.0, 6.0, N_HEADS, dtype=f32)[None, :] + 0.1 * nrm(ks[7], (DEPTH, N_HEADS), f32)
    b_gates = jnp.concatenate([b_igate, b_fgate], axis=-1)
    conv_w = 0.5 * nrm(ks[8], (DEPTH, CONV_WIDTH, 2 * D_MLSTM), f32)
    conv_b = 0.02 * nrm(ks[9], (DEPTH, 2 * D_MLSTM), f32)
    w_pool = POOL_GROUP_DIM ** -0.5 * nrm(ks[10], (DEPTH, N_POOL_GROUPS, POOL_GROUP_DIM, POOL_GROUP_DIM), f32)
    ls_pool = 1.0 + 0.1 * nrm(ks[11], (DEPTH, D_POOL), f32)
    mh_norm_g = 1.0 + 0.02 * nrm(ks[12], (DEPTH, D_MLSTM), f32)
    w_out = D_MIX ** -0.5 * nrm(ks[13], (DEPTH, D_MIX, D_MODEL), f32)
    final_g = 1.0 + 0.02 * nrm(ks[14], (D_MODEL,), f32)
    return {"x": x, "c": c, "norm_g": norm_g, "w_ada": w_ada, "b_ada": b_ada,
            "w_in": w_in, "b_gates": b_gates, "conv_w": conv_w, "conv_b": conv_b,
            "w_pool": w_pool, "ls_pool": ls_pool, "mh_norm_g": mh_norm_g,
            "w_out": w_out, "final_g": final_g}


def reference(x, c, norm_g, w_ada, b_ada, w_in, b_gates, conv_w, conv_b,
              w_pool, ls_pool, mh_norm_g, w_out, final_g):
    B, S, _ = x.shape
    for l in range(DEPTH):
        mod = jax.nn.silu(c) @ w_ada[l] + b_ada[l]
        shift, scale, gate = jnp.split(mod, 3, axis=-1)
        h = rms_norm(x, norm_g[l]) * (1.0 + scale[:, None, :]) + shift[:, None, :]
        proj = h @ w_in[l]

        u = proj[..., OFF_U:OFF_ZP]
        z_pool = proj[..., OFF_ZP:OFF_Q]
        pool_out = causal_pool_mixer(u, w_pool[l], ls_pool[l]) * jax.nn.silu(z_pool)

        qk = jax.nn.silu(causal_depthwise_conv(proj[..., OFF_Q:OFF_V], conv_w[l], conv_b[l]))
        q = qk[..., :D_MLSTM].reshape(B, S, N_HEADS, HEAD_DIM)
        k = qk[..., D_MLSTM:].reshape(B, S, N_HEADS, HEAD_DIM)
        v = proj[..., OFF_V:OFF_O].reshape(B, S, N_HEADS, HEAD_DIM)
        o_gate = jax.nn.sigmoid(proj[..., OFF_O:OFF_ZM])
        z_mlstm = proj[..., OFF_ZM:OFF_G]
        gates = (proj[..., OFF_G:] + b_gates[l]).astype(jnp.float32)
        ig = gates[..., :N_HEADS]
        lf = jax.nn.log_sigmoid(gates[..., N_HEADS:])
        hm = mlstm_chunkwise(q, k, v, ig, lf)
        hm = hm * lax.rsqrt(jnp.mean(hm * hm, axis=-1, keepdims=True) + EPS)
        hm = hm.reshape(B, S, D_MLSTM) * mh_norm_g[l].astype(jnp.float32)
        mlstm_out = hm.astype(x.dtype) * o_gate * jax.nn.silu(z_mlstm)

        mix = jnp.concatenate([pool_out, mlstm_out], axis=-1)
        x = x + gate[:, None, :] * (mix @ w_out[l])
    return rms_norm(x, final_g)
```

```cpp
#include <hip/hip_runtime.h>
#include <hip/hip_cooperative_groups.h>
#include <cstdio>
namespace cg = cooperative_groups;
namespace pg8 {
#define PG8_LAS __attribute__((address_space(3)))
typedef unsigned short bf16_t;
typedef short bf16x8 __attribute__((ext_vector_type(8)));
typedef float f32x4 __attribute__((ext_vector_type(4)));
typedef unsigned u32x4 __attribute__((ext_vector_type(4)));
constexpr int BM = 256, BK = 64, HALF = 128, HTB = HALF * BK * 2  , STAGE_BYTES = 8 * HTB, NXCD = 8, WGM = 8;

__host__ __device__ __forceinline__ int lds_byte(int r, int c) { const int st = (r >> 4) * 2 + (c >> 5), rr = r & 15, cc = c & 31, ob = rr * 64 + cc * 2; return st * 1024 + (ob ^ (((ob >> 9) & 1) << 5)); }
__host__ __device__ __forceinline__ void stage_rc(int b, int& R, int& C) { const int st = b / 1024, sb = b % 1024, swz = sb ^ (((sb >> 9) & 1) << 5); R = (st >> 1) * 16 + swz / 64; C = (st & 1) * 32 + (swz % 64) / 2; }
__host__ __device__ __forceinline__ int perm32(int rho) { const int n = rho >> 4, i = rho & 15; return 8 * (i >> 2) + 4 * n + (i & 3); }

struct Unit { int pm, pn; };
struct Gemm { const bf16_t* A; const bf16_t* Bt; int M, N, K; };

struct StaticOrder {
    int nM, nN, nwg, G, c;
    __host__ __device__ void init(int M, int N, int G_, int c_) { nM = M / BM; nN = N / BM; nwg = nM * nN; G = G_; c = c_; }
    __host__ __device__ bool next(int i, Unit& u) const {
        const long L = (long)i * G + c; if (L >= nwg) return false;
        int wgid = (int)L; { const int q = nwg / NXCD, r = nwg % NXCD, xcd = wgid % NXCD, off = wgid / NXCD; wgid = (xcd < r ? xcd * (q + 1) : r * (q + 1) + (xcd - r) * q) + off; }
        const int nig = WGM * nN, gid = wgid / nig, fm = gid * WGM, gsz = (nM - fm) < WGM ? (nM - fm) : WGM;
        u.pm = fm + ((wgid % nig) % gsz); u.pn = (wgid % nig) / gsz; return true;
    }
    __device__ __forceinline__ void a_ready(const Unit&) const {}
    __device__ __forceinline__ void done(const Unit&) const {}
};
__device__ __forceinline__ unsigned cvt_pk_bf16(float lo, float hi) { unsigned r; asm volatile("v_cvt_pk_bf16_f32 %0, %1, %2" : "=v"(r) : "v"(lo), "v"(hi)); return r; }
typedef float f32x2 __attribute__((ext_vector_type(2)));
__device__ __forceinline__ f32x2 gelu_pk(f32x2 v) {
    const f32x2 av = __builtin_elementwise_abs(v), d = av * 0.2316418882f + 1.0f;
    f32x2 t; t.x = __builtin_amdgcn_rcpf(d.x); t.y = __builtin_amdgcn_rcpf(d.y);
    f32x2 q = t * 0.5307027145f + (-0.7265760135f); q = q * t + 0.7107068705f; q = q * t + (-0.142248368f); q = q * t + 0.127414796f; q = q * t;
    const f32x2 s = (v * v) * (-0.72134752044f);
    f32x2 e; e.x = __builtin_amdgcn_exp2f(s.x); e.y = __builtin_amdgcn_exp2f(s.y);
    const f32x2 m = v * (q * e), r = v - m;
    f32x2 o; o.x = v.x < 0.f ? m.x : r.x; o.y = v.y < 0.f ? m.y : r.y; return o;
}

struct EpiF32 {
    static constexpr bool PERM = false, AFTER_DRAIN = false;
    float* C; int ldc; const float* bias;
    __device__ __forceinline__ void operator()(const f32x4 (&acc)[2][2][4][2], const Unit& u, int wr, int wc, int fr, int fq) const {
        const int row0 = u.pm * BM + wr * 64 + fr, col0 = u.pn * BM + wc * 32 + 4 * fq;
        f32x4 bv[2][2];
#pragma unroll
        for (int bj = 0; bj < 2; ++bj)
#pragma unroll
            for (int n = 0; n < 2; ++n) bv[bj][n] = bias ? *(const f32x4*)(bias + col0 + bj * HALF + n * 16) : (f32x4){0.f, 0.f, 0.f, 0.f};
#pragma unroll
        for (int ai = 0; ai < 2; ++ai)
#pragma unroll
            for (int m = 0; m < 4; ++m) { float* rowp = C + (size_t)(row0 + ai * HALF + m * 16) * ldc + col0;
#pragma unroll
                for (int bj = 0; bj < 2; ++bj)
#pragma unroll
                    for (int n = 0; n < 2; ++n) *(f32x4*)(rowp + bj * HALF + n * 16) = acc[ai][bj][m][n] + bv[bj][n]; }
    }
};
template <int ACT  > struct EpiBf16 {
    static constexpr bool PERM = true, AFTER_DRAIN = false;
    bf16_t* O; int ldc; const float* bias; int split_cols; size_t split_stride;
    __device__ __forceinline__ void operator()(const f32x4 (&acc)[2][2][4][2], const Unit& u, int wr, int wc, int fr, int fq) const {
        const int row0 = u.pm * BM + wr * 64 + fr; int colt = u.pn * BM; bf16_t* base = O;
        if (split_cols) { const int t = colt / split_cols; base += (size_t)t * split_stride; colt -= t * split_cols; }
        const int col0 = colt + wc * 32 + 8 * fq, bcol0 = u.pn * BM + wc * 32 + 8 * fq;
        f32x4 bv[2][2];
#pragma unroll
        for (int bj = 0; bj < 2; ++bj)
#pragma unroll
            for (int n = 0; n < 2; ++n) bv[bj][n] = bias ? *(const f32x4*)(bias + bcol0 + bj * HALF + 4 * n) : (f32x4){0.f, 0.f, 0.f, 0.f};
#pragma unroll
        for (int ai = 0; ai < 2; ++ai)
#pragma unroll
            for (int m = 0; m < 4; ++m) { bf16_t* rowp = base + (size_t)(row0 + ai * HALF + m * 16) * ldc + col0;
#pragma unroll
                for (int bj = 0; bj < 2; ++bj) { f32x4 v0 = acc[ai][bj][m][0] + bv[bj][0], v1 = acc[ai][bj][m][1] + bv[bj][1];
                    if (ACT == 1) { f32x2 a = gelu_pk((f32x2){v0[0], v0[1]}), b = gelu_pk((f32x2){v0[2], v0[3]}), c = gelu_pk((f32x2){v1[0], v1[1]}), d = gelu_pk((f32x2){v1[2], v1[3]});
                        v0 = (f32x4){a.x, a.y, b.x, b.y}; v1 = (f32x4){c.x, c.y, d.x, d.y}; }
                    if (ACT == 2) {
#pragma unroll
                        for (int j = 0; j < 4; ++j) { v0[j] = 0.5f * v0[j] * (1.0f + erff(v0[j] * 0.70710678f)); v1[j] = 0.5f * v1[j] * (1.0f + erff(v1[j] * 0.70710678f)); } }
                    u32x4 w; w.x = cvt_pk_bf16(v0[0], v0[1]); w.y = cvt_pk_bf16(v0[2], v0[3]); w.z = cvt_pk_bf16(v1[0], v1[1]); w.w = cvt_pk_bf16(v1[2], v1[3]);
                    *(u32x4*)(rowp + bj * HALF) = w; } }
    }
};
template <class Epi, class Sched, bool STAMP = false>
__device__ __forceinline__ void gemm_phase(PG8_LAS unsigned char* lds, const Gemm g, const Sched& S, const Epi& E, unsigned long long* stamps) {
    const int tid = threadIdx.x, wid = __builtin_amdgcn_readfirstlane(tid >> 6), lane = tid & 63, wr = wid >> 2, wc = wid & 3, fr = lane & 15, fq = lane >> 4;
    const int K = g.K, nt = K / BK;
    int ts_lo = 0, ts_hi = 0, nts = 0; const unsigned long long rt_entry = STAMP ? (unsigned long long)wall_clock64() : 0ull;
#define PG8_STAMP() do { if (STAMP && wid == 0 && nts < 64) { const unsigned long long _c = (unsigned long long)clock64(); \
        ts_lo = (lane == nts) ? (int)(unsigned)_c : ts_lo; ts_hi = (lane == nts) ? (int)(unsigned)(_c >> 32) : ts_hi; ++nts; } } while (0)
    PG8_STAMP();
    unsigned voffA[2], voffB[2];
#pragma unroll
    for (int i = 0; i < 2; ++i) { int R, C; stage_rc(tid * 16 + i * 8192, R, C); const int Rb = Epi::PERM ? ((R & ~31) + perm32(R & 31)) : R;
        voffA[i] = (unsigned)(R * K + C) * 2u; voffB[i] = (unsigned)(Rb * K + C) * 2u; }
    const size_t kstep = (size_t)(BK * 2);
    const size_t hstep = (size_t)HALF * K * 2;
    const size_t tstep = 2 * hstep;
    const unsigned ldsw = (unsigned)wid * 1024u;
    const int aoff = lds_byte(wr * 64 + fr, fq * 8), boff = lds_byte(wc * 32 + fr, fq * 8);
#define PG8_SA(b, h) (((b) * 2 + (h)) * HTB)
#define PG8_SB(b, h) ((4 + (b) * 2 + (h)) * HTB)
#define PG8_STAGE(bufoff, gbase, voff) do { _Pragma("unroll") for (int _i = 0; _i < 2; ++_i) \
        __builtin_amdgcn_global_load_lds((const unsigned*)((const char*)(gbase) + (voff)[_i]), (PG8_LAS unsigned*)(lds + (bufoff) + ldsw + _i * 8192), 16, 0, 0); } while (0)
#define PG8_LDA(dst, b, h) do { _Pragma("unroll") for (int m = 0; m < 4; ++m) _Pragma("unroll") for (int k = 0; k < 2; ++k) dst[m][k] = *(const PG8_LAS bf16x8*)(lds + PG8_SA(b, h) + aoff + m * 2048 + k * 1024); } while (0)
#define PG8_LDB(dst, b, h) do { _Pragma("unroll") for (int n = 0; n < 2; ++n) _Pragma("unroll") for (int k = 0; k < 2; ++k) dst[n][k] = *(const PG8_LAS bf16x8*)(lds + PG8_SB(b, h) + boff + n * 2048 + k * 1024); } while (0)
#define PG8_MMA(ai, bj, At, Bt) do { __builtin_amdgcn_s_setprio(1); _Pragma("unroll") for (int m = 0; m < 4; ++m) _Pragma("unroll") for (int n = 0; n < 2; ++n) _Pragma("unroll") for (int k = 0; k < 2; ++k) \
        acc[ai][bj][m][n] = __builtin_amdgcn_mfma_f32_16x16x32_bf16(Bt[n][k], At[m][k], acc[ai][bj][m][n], 0, 0, 0); __builtin_amdgcn_s_setprio(0); } while (0)
#define PG8_WAIT_V(n) asm volatile("s_waitcnt vmcnt(" #n ")" ::: "memory")
#define PG8_WAIT_L(n) asm volatile("s_waitcnt lgkmcnt(" #n ")" ::: "memory")
#define PG8_BAR __builtin_amdgcn_s_barrier()
#define PG8_SCHED __builtin_amdgcn_sched_barrier(0)
    Unit cur, nxt; int ui = 0;
    if (!S.next(0, cur)) return;
    f32x4 acc[2][2][4][2];
#pragma unroll
    for (int a = 0; a < 2; ++a)
#pragma unroll
        for (int b = 0; b < 2; ++b)
#pragma unroll
            for (int m = 0; m < 4; ++m)
#pragma unroll
                for (int n = 0; n < 2; ++n) acc[a][b][m][n] = (f32x4){0.f, 0.f, 0.f, 0.f};
    bf16x8 At[4][2], B0[2][2], B1[2][2];
    const char* cA = (const char*)g.A + (size_t)cur.pm * tstep; const char* cB = (const char*)g.Bt + (size_t)cur.pn * tstep;
    S.a_ready(cur);
    PG8_STAGE(PG8_SB(0, 0), cB, voffB); PG8_STAGE(PG8_SA(0, 0), cA, voffA); PG8_STAGE(PG8_SB(0, 1), cB + hstep, voffB); PG8_STAGE(PG8_SA(0, 1), cA + hstep, voffA);
    if (wr == 1) PG8_BAR;
    PG8_WAIT_V(4); PG8_BAR;
    PG8_STAGE(PG8_SB(1, 0), cB + kstep, voffB); PG8_STAGE(PG8_SA(1, 0), cA + kstep, voffA); PG8_STAGE(PG8_SB(1, 1), cB + hstep + kstep, voffB);
    PG8_WAIT_V(6); PG8_BAR;
    PG8_STAMP();
    for (;;) {
        const bool has_next = S.next(ui + 1, nxt);
        const char* nA = has_next ? (const char*)g.A + (size_t)nxt.pm * tstep : cA; const char* nB = has_next ? (const char*)g.Bt + (size_t)nxt.pn * tstep : cB;
        for (int t = 0; t < nt; t += 2) {
            const bool last = (t == nt - 2);
            const char* a1 = cA + (size_t)(t + 1) * kstep;
            const char* a2 = last ? nA : cA + (size_t)(t + 2) * kstep; const char* b2 = last ? nB : cB + (size_t)(t + 2) * kstep;
            const char* a3 = a2 + kstep; const char* b3 = b2 + kstep;
            if (last && has_next) S.a_ready(nxt);
            PG8_LDB(B0, 0, 0); PG8_SCHED; PG8_LDA(At, 0, 0); PG8_STAGE(PG8_SA(1, 1), a1 + hstep, voffA);
            PG8_WAIT_L(8); PG8_BAR; PG8_WAIT_L(0); PG8_MMA(0, 0, At, B0); PG8_BAR; PG8_SCHED;
            PG8_LDB(B1, 0, 1); PG8_STAGE(PG8_SB(0, 0), b2, voffB);
            PG8_BAR; PG8_WAIT_L(0); PG8_MMA(0, 1, At, B1); PG8_BAR;
            PG8_LDA(At, 0, 1); PG8_STAGE(PG8_SA(0, 0), a2, voffA);
            PG8_BAR; PG8_WAIT_L(0); PG8_MMA(1, 0, At, B0); PG8_BAR; PG8_SCHED;
            PG8_STAGE(PG8_SB(0, 1), b2 + hstep, voffB);
            PG8_WAIT_V(6); PG8_BAR; PG8_MMA(1, 1, At, B1); PG8_BAR;
            PG8_LDB(B0, 1, 0); PG8_SCHED; PG8_LDA(At, 1, 0); PG8_STAGE(PG8_SA(0, 1), a2 + hstep, voffA);
            PG8_WAIT_L(8); PG8_BAR; PG8_WAIT_L(0); PG8_MMA(0, 0, At, B0); PG8_BAR; PG8_SCHED;
            PG8_LDB(B1, 1, 1); PG8_STAGE(PG8_SB(1, 0), b3, voffB);
            PG8_BAR; PG8_WAIT_L(0); PG8_MMA(0, 1, At, B1); PG8_BAR;
            PG8_LDA(At, 1, 1); PG8_STAGE(PG8_SA(1, 0), a3, voffA);
            PG8_BAR; PG8_WAIT_L(0); PG8_MMA(1, 0, At, B0); PG8_BAR; PG8_SCHED;
            PG8_STAGE(PG8_SB(1, 1), b3 + hstep, voffB);
            PG8_WAIT_V(6); PG8_BAR; PG8_MMA(1, 1, At, B1); PG8_BAR;
        }
        PG8_STAMP();
        if constexpr (!Epi::AFTER_DRAIN) { E(acc, cur, wr, wc, fr, fq); S.done(cur); }
        PG8_STAMP();
        if (!has_next) break;
#pragma unroll
        for (int a = 0; a < 2; ++a)
#pragma unroll
            for (int b = 0; b < 2; ++b)
#pragma unroll
                for (int m = 0; m < 4; ++m)
#pragma unroll
                    for (int n = 0; n < 2; ++n) acc[a][b][m][n] = (f32x4){0.f, 0.f, 0.f, 0.f};
        cur = nxt; cA = nA; cB = nB; ++ui;
    }
    PG8_WAIT_V(0);
    if (wr == 0) PG8_BAR;
    PG8_BAR;
    if constexpr (Epi::AFTER_DRAIN) { E.fused(acc, cur, wr, wc, fr, fq, lds, wid, lane); S.done(cur); }
    PG8_STAMP();
    if (STAMP && wid == 0) { stamps[lane] = lane < nts ? (((unsigned long long)(unsigned)ts_hi << 32) | (unsigned)ts_lo) : 0ull;
        if (lane == 62) stamps[62] = rt_entry; if (lane == 63) stamps[63] = (unsigned long long)wall_clock64(); }
#undef PG8_STAMP
#undef PG8_SA
#undef PG8_SB
#undef PG8_STAGE
#undef PG8_LDA
#undef PG8_LDB
#undef PG8_MMA
#undef PG8_WAIT_V
#undef PG8_WAIT_L
#undef PG8_BAR
#undef PG8_SCHED
}
}

#define LAS __attribute__((address_space(3)))
typedef unsigned short bf16_t;
typedef short bf16x8 __attribute__((ext_vector_type(8)));
typedef float f32x4 __attribute__((ext_vector_type(4)));
typedef float f32x2 __attribute__((ext_vector_type(2)));
typedef unsigned u32x4 __attribute__((ext_vector_type(4)));
typedef unsigned u32x2 __attribute__((ext_vector_type(2)));

constexpr int NB = 4, SEQ = 8192, DM = 1024, MROWS = NB * SEQ;
constexpr int NPROJ = 3584, LDW = 3592;
constexpr int C_U = 0, C_ZP = 512, C_Q = 1024, C_K = 1536, C_V = 2048, C_O = 2560, C_ZM = 3072, C_G = 3584;
constexpr int NH = 4, DH = 128, CH = 128, NCH = SEQ / CH, NUNIT = NB * NH * NCH;
constexpr float EPS = 1e-6f;
constexpr int NTHREADS = 512, NWAVES = 8;
constexpr int LP = 136;
constexpr size_t WS_WIN = 0;
constexpr size_t WS_WOUT = WS_WIN + (size_t)NPROJ * DM * 2;
constexpr size_t WS_WPOOL = WS_WOUT + (size_t)DM * DM * 2;
constexpr size_t WS_MODP = WS_WPOOL + (size_t)4 * 128 * 128 * 2;
constexpr size_t WS_GATES = WS_MODP + (size_t)4 * NB * 3072 * 4;
constexpr size_t WS_DN = WS_GATES + (size_t)MROWS * 8 * 4;
constexpr size_t WS_NPREV = WS_DN + (size_t)NUNIT * 128 * 4;
constexpr size_t WS_MLOC = WS_NPREV + (size_t)NUNIT * 128 * 4;
constexpr size_t WS_BL = WS_MLOC + (size_t)NUNIT * 4;
constexpr size_t WS_MPREV = WS_BL + (size_t)NUNIT * 4;
constexpr size_t WS_H = WS_MPREV + (size_t)NUNIT * 4;
constexpr size_t WS_PROJ = WS_H + (size_t)MROWS * DM * 2;
constexpr size_t WS_QC = WS_PROJ + (size_t)MROWS * NPROJ * 2;
constexpr size_t WS_KC = WS_QC + (size_t)MROWS * 512 * 2;
constexpr size_t WS_END = WS_KC + (size_t)MROWS * 512 * 2;
constexpr size_t OUT_DC = 0, OUT_CPREV = (size_t)NUNIT * 16384 * 4;
constexpr int LDS_BYTES = 150 * 1024;

struct Args { const float* in[14]; float* out; unsigned char* ws; int ph_lo, ph_hi; };

struct Ctx {
    const float *x, *c, *norm_g, *w_ada, *b_ada, *w_in, *b_gates, *conv_w, *conv_b, *w_pool, *ls_pool, *mh_norm_g, *w_out, *final_g;
    float* out; unsigned char* ws;
    int tid, lane, wave;
};

__device__ __forceinline__ unsigned pk2(float lo, float hi) { unsigned r; asm volatile("v_cvt_pk_bf16_f32 %0, %1, %2" : "=v"(r) : "v"(lo), "v"(hi)); return r; }
__device__ __forceinline__ float bflo(unsigned u) { return __uint_as_float(u << 16); }
__device__ __forceinline__ float bfhi(unsigned u) { return __uint_as_float(u & 0xffff0000u); }
__device__ __forceinline__ float fsilu(float v) { return v * __builtin_amdgcn_rcpf(1.0f + __expf(-v)); }
__device__ __forceinline__ float fsigm(float v) { return __builtin_amdgcn_rcpf(1.0f + __expf(-v)); }
__device__ __forceinline__ float wave_sum(float v) {
#pragma unroll
    for (int o = 1; o < 64; o <<= 1) v += __shfl_xor(v, o);
    return v;
}
__device__ __forceinline__ float wave_max(float v) {
#pragma unroll
    for (int o = 1; o < 64; o <<= 1) v = fmaxf(v, __shfl_xor(v, o));
    return v;
}
#define LDS_WAIT() asm volatile("s_waitcnt lgkmcnt(0)" ::: "memory")
#define MFMA16(a, b, c) __builtin_amdgcn_mfma_f32_16x16x32_bf16((a), (b), (c), 0, 0, 0)

__device__ __forceinline__ f32x4 mod4(const float* b_ada, const unsigned char* ws, int b, int j) {
    const float* mp = (const float*)(ws + WS_MODP);
    f32x4 v = *(const f32x4*)(b_ada + j);
#pragma unroll
    for (int ks = 0; ks < 4; ++ks) v += *(const f32x4*)(mp + ((size_t)ks * NB + b) * 3072 + j);
    return v;
}

__device__ __forceinline__ void p0_transpose_item(const float* W, int K, int ldw, int nblk, bf16_t* WT, LAS float* scr, int item, int lane) {
    const int kb = item / nblk, nb = item % nblk, k0 = 64 * kb, n0 = 32 * nb;
#pragma unroll 8
    for (int i = 0; i < 32; ++i) { const int kk = 2 * i + (lane >> 5); scr[kk * 33 + (lane & 31)] = W[(size_t)(k0 + kk) * ldw + n0 + (lane & 31)]; }
    LDS_WAIT();
    const int c = lane & 7;
#pragma unroll
    for (int j = 0; j < 4; ++j) { const int n = (lane >> 3) + 8 * j; const LAS float* s = scr + (8 * c) * 33 + n;
        u32x4 o; o.x = pk2(s[0 * 33], s[1 * 33]); o.y = pk2(s[2 * 33], s[3 * 33]); o.z = pk2(s[4 * 33], s[5 * 33]); o.w = pk2(s[6 * 33], s[7 * 33]);
        *(u32x4*)(WT + (size_t)(n0 + n) * K + k0 + 8 * c) = o; }
    LDS_WAIT();
}
__device__ __forceinline__ void p0_adaln_item(const Ctx& C, int item) {
    const int cgp = item >> 2, ks = item & 3, lane = C.lane, kq = lane >> 3, j4 = lane & 7, j0 = 32 * cgp + 4 * j4;
    f32x4 acc[NB];
#pragma unroll
    for (int b = 0; b < NB; ++b) acc[b] = (f32x4){0.f, 0.f, 0.f, 0.f};
#pragma unroll 8
    for (int i = 0; i < 32; ++i) {
        const int k = 256 * ks + kq + 8 * i;
        const f32x4 w = *(const f32x4*)(C.w_ada + (size_t)k * 3072 + j0);
#pragma unroll
        for (int b = 0; b < NB; ++b) { const float s = fsilu(C.c[b * DM + k]); acc[b] += w * s; }
    }
#pragma unroll
    for (int b = 0; b < NB; ++b)
#pragma unroll
        for (int e = 0; e < 4; ++e) { float v = acc[b][e]; v += __shfl_xor(v, 8); v += __shfl_xor(v, 16); v += __shfl_xor(v, 32); acc[b][e] = v; }
    if (kq == 0) {
        float* mp = (float*)(C.ws + WS_MODP);
#pragma unroll
        for (int b = 0; b < NB; ++b) *(f32x4*)(mp + ((size_t)ks * NB + b) * 3072 + j0) = acc[b];
    }
}
__device__ __forceinline__ void p0_phase(const Ctx& C, LAS unsigned char* lds) {
    LAS float* scr = (LAS float*)(lds + C.wave * 8704);
    const int gw = blockIdx.x * NWAVES + C.wave, NGW = gridDim.x * NWAVES;
    constexpr int I_ADA = 96 * 4, I_IN = 16 * (NPROJ / 32), I_OUT = 16 * 32, I_POOL = 4 * 8;
    bf16_t* win = (bf16_t*)(C.ws + WS_WIN); bf16_t* wout = (bf16_t*)(C.ws + WS_WOUT); bf16_t* wpool = (bf16_t*)(C.ws + WS_WPOOL);
    for (int it = gw; it < I_ADA + I_IN + I_OUT + I_POOL; it += NGW) {
        int r = it;
        if (r < I_ADA) { p0_adaln_item(C, r); continue; } r -= I_ADA;
        if (r < I_IN) { p0_transpose_item(C.w_in, DM, LDW, NPROJ / 32, win, scr, r, C.lane); continue; } r -= I_IN;
        if (r < I_OUT) { p0_transpose_item(C.w_out, DM, DM, 32, wout, scr, r, C.lane); continue; } r -= I_OUT;
        const int g = r >> 3; p0_transpose_item(C.w_pool + (size_t)g * 16384, 128, 128, 4, wpool + (size_t)g * 16384, scr, r & 7, C.lane);
    }
}

__device__ __forceinline__ void p1_phase(const Ctx& C) {
    const int gw = blockIdx.x * NWAVES + C.wave, NGW = gridDim.x * NWAVES, lane = C.lane;
    bf16_t* H = (bf16_t*)(C.ws + WS_H); float* G = (float*)(C.ws + WS_GATES);
    f32x4 wg[4][4][2];
#pragma unroll
    for (int j = 0; j < 4; ++j)
#pragma unroll
        for (int i = 0; i < 4; ++i) { const float* p = C.w_in + (size_t)(4 * lane + 256 * j + i) * LDW + C_G; wg[j][i][0] = *(const f32x4*)p; wg[j][i][1] = *(const f32x4*)(p + 4); }
    const f32x4 bg0 = *(const f32x4*)(C.b_gates), bg1 = *(const f32x4*)(C.b_gates + 4);
    constexpr int RPW = 16;
    for (int item = gw; item < MROWS / RPW; item += NGW) {
        const int m0 = item * RPW, b = m0 / SEQ;
        f32x4 ga[4], gb[4];
#pragma unroll
        for (int j = 0; j < 4; ++j) { const int k = 4 * lane + 256 * j; const f32x4 sh = mod4(C.b_ada, C.ws, b, k), sc = mod4(C.b_ada, C.ws, b, 1024 + k), ng = *(const f32x4*)(C.norm_g + k);
            ga[j] = ng * (sc + 1.0f); gb[j] = sh; }
        for (int r = 0; r < RPW; ++r) {
            const int m = m0 + r;
            const f32x4* xr = (const f32x4*)(C.x + (size_t)m * DM) + lane;
            f32x4 v[4]; float ss = 0.f;
#pragma unroll
            for (int j = 0; j < 4; ++j) { v[j] = xr[64 * j]; ss += (v[j].x * v[j].x + v[j].y * v[j].y) + (v[j].z * v[j].z + v[j].w * v[j].w); }
            const float rstd = 1.0f / sqrtf(wave_sum(ss) * (1.0f / DM) + EPS);
            f32x4 g0 = (f32x4){0.f, 0.f, 0.f, 0.f}, g1 = g0;
            u32x2* hp = (u32x2*)(H + (size_t)m * DM) + lane;
#pragma unroll
            for (int j = 0; j < 4; ++j) {
                const f32x4 hv = v[j] * rstd * ga[j] + gb[j];
                u32x2 o; o.x = pk2(hv.x, hv.y); o.y = pk2(hv.z, hv.w); hp[64 * j] = o;
#pragma unroll
                for (int i = 0; i < 4; ++i) { g0 += wg[j][i][0] * hv[i]; g1 += wg[j][i][1] * hv[i]; }
            }
#pragma unroll
            for (int e = 0; e < 4; ++e) { g0[e] = wave_sum(g0[e]); g1[e] = wave_sum(g1[e]); }
            if (lane == 0) {
                g0 += bg0; g1 += bg1;
                f32x4 lf;
#pragma unroll
                for (int e = 0; e < 4; ++e) lf[e] = fminf(g1[e], 0.f) - log1pf(__expf(-fabsf(g1[e])));
                *(f32x4*)(G + (size_t)m * 8) = g0; *(f32x4*)(G + (size_t)m * 8 + 4) = lf;
            }
        }
    }
}

__device__ __forceinline__ void conv_qk(const Ctx& C, const bf16_t* proj, int colbase  , int wcol  , size_t row0, int chunk, int dp, int seg, float scale, float (&o)[16][2]) {
    float w[4][2], bias[2];
#pragma unroll
    for (int j = 0; j < 4; ++j) { const f32x2 t = *(const f32x2*)(C.conv_w + (size_t)j * 1024 + wcol + 2 * dp); w[j][0] = t.x; w[j][1] = t.y; }
    { const f32x2 t = *(const f32x2*)(C.conv_b + wcol + 2 * dp); bias[0] = t.x; bias[1] = t.y; }
    float xv[19][2];
#pragma unroll
    for (int i = 0; i < 19; ++i) {
        const int s = seg * 16 - 3 + i;
        unsigned u = 0u;
        if (chunk > 0 || s >= 0) u = *(const unsigned*)(proj + (row0 + s) * (size_t)NPROJ + colbase + 2 * dp);
        xv[i][0] = bflo(u); xv[i][1] = bfhi(u);
    }
#pragma unroll
    for (int i = 0; i < 16; ++i)
#pragma unroll
        for (int e = 0; e < 2; ++e) {
            const float y = bias[e] + w[0][e] * xv[i][e] + w[1][e] * xv[i + 1][e] + w[2][e] * xv[i + 2][e] + w[3][e] * xv[i + 3][e];
            o[i][e] = fsilu(y) * scale;
        }
}
__device__ __forceinline__ void mlstm_a_unit(const Ctx& C, LAS unsigned char* lds, int unit) {
    const int tid = C.tid, lane = C.lane, wave = C.wave;
    const int bh = unit >> 6, chunk = unit & 63, b = bh >> 2, h = bh & 3;
    const size_t row0 = (size_t)b * SEQ + (size_t)chunk * CH;
    LAS bf16_t* Kt = (LAS bf16_t*)lds;
    LAS bf16_t* Vt = (LAS bf16_t*)(lds + 128 * LP * 2);
    LAS float* garr = (LAS float*)(lds + (128 + 144) * LP * 2);
    const bf16_t* proj = (const bf16_t*)(C.ws + WS_PROJ);
    const float* G = (const float*)(C.ws + WS_GATES);
    if (wave == 0) {
        const float ig0 = G[(row0 + 2 * lane) * 8 + h], ig1 = G[(row0 + 2 * lane + 1) * 8 + h];
        const float lf0 = G[(row0 + 2 * lane) * 8 + 4 + h], lf1 = G[(row0 + 2 * lane + 1) * 8 + 4 + h];
        float incl = lf0 + lf1;
#pragma unroll
        for (int o = 1; o < 64; o <<= 1) { const float t = __shfl_up(incl, o); if (lane >= o) incl += t; }
        const float b1 = incl, b0 = incl - lf1, bL = __shfl(incl, 63);
        const float wl0 = bL - b0 + ig0, wl1 = bL - b1 + ig1;
        const float mloc = wave_max(fmaxf(wl0, wl1));
        garr[2 * lane] = __expf(wl0 - mloc); garr[2 * lane + 1] = __expf(wl1 - mloc);
        if (lane == 0) { ((float*)(C.ws + WS_MLOC))[unit] = mloc; ((float*)(C.ws + WS_BL))[unit] = bL; }
    }
    const int dp = tid & 63, seg = tid >> 6;
    {
        float o[16][2];
        conv_qk(C, proj, C_K + h * 128, 512 + h * 128, row0, chunk, dp, seg, 0.08838834764831845f, o);
        bf16_t* kc = (bf16_t*)(C.ws + WS_KC);
#pragma unroll
        for (int i = 0; i < 16; ++i) *(unsigned*)(kc + (row0 + seg * 16 + i) * 512 + h * 128 + 2 * dp) = pk2(o[i][0], o[i][1]);
#pragma unroll
        for (int e = 0; e < 2; ++e) {
            u32x4 lo, hi;
            lo.x = pk2(o[0][e], o[1][e]); lo.y = pk2(o[2][e], o[3][e]); lo.z = pk2(o[4][e], o[5][e]); lo.w = pk2(o[6][e], o[7][e]);
            hi.x = pk2(o[8][e], o[9][e]); hi.y = pk2(o[10][e], o[11][e]); hi.z = pk2(o[12][e], o[13][e]); hi.w = pk2(o[14][e], o[15][e]);
            LAS u32x4* p = (LAS u32x4*)(Kt + (2 * dp + e) * LP + seg * 16); p[0] = lo; p[1] = hi;
        }
    }
    {
        float o[16][2];
        conv_qk(C, proj, C_Q + h * 128, h * 128, row0, chunk, dp, seg, 1.0f, o);
        bf16_t* qc = (bf16_t*)(C.ws + WS_QC);
#pragma unroll
        for (int i = 0; i < 16; ++i) *(unsigned*)(qc + (row0 + seg * 16 + i) * 512 + h * 128 + 2 * dp) = pk2(o[i][0], o[i][1]);
    }
    unsigned vraw[16];
#pragma unroll
    for (int i = 0; i < 16; ++i) vraw[i] = *(const unsigned*)(proj + (row0 + seg * 16 + i) * (size_t)NPROJ + C_V + h * 128 + 2 * dp);
    __syncthreads();
    {
        float wv[16];
#pragma unroll
        for (int i = 0; i < 16; i += 4) { const f32x4 t = *(const LAS f32x4*)(garr + seg * 16 + i); wv[i] = t.x; wv[i + 1] = t.y; wv[i + 2] = t.z; wv[i + 3] = t.w; }
#pragma unroll
        for (int e = 0; e < 2; ++e) {
            float f[16];
#pragma unroll
            for (int i = 0; i < 16; ++i) f[i] = (e ? bfhi(vraw[i]) : bflo(vraw[i])) * wv[i];
            u32x4 lo, hi;
            lo.x = pk2(f[0], f[1]); lo.y = pk2(f[2], f[3]); lo.z = pk2(f[4], f[5]); lo.w = pk2(f[6], f[7]);
            hi.x = pk2(f[8], f[9]); hi.y = pk2(f[10], f[11]); hi.z = pk2(f[12], f[13]); hi.w = pk2(f[14], f[15]);
            LAS u32x4* p = (LAS u32x4*)(Vt + (2 * dp + e) * LP + seg * 16); p[0] = lo; p[1] = hi;
        }
        const int r = 128 + (tid >> 5), s4 = (tid & 31) * 4;
        u32x2 z; z.x = 0u; z.y = 0u;
        if (r == 128) { const f32x4 t = *(const LAS f32x4*)(garr + s4); z.x = pk2(t.x, t.y); z.y = pk2(t.z, t.w); }
        *(LAS u32x2*)(Vt + r * LP + s4) = z;
    }
    __syncthreads();
    f32x4 acc[8], accn = (f32x4){0.f, 0.f, 0.f, 0.f};
#pragma unroll
    for (int nt = 0; nt < 8; ++nt) acc[nt] = (f32x4){0.f, 0.f, 0.f, 0.f};
    const int fr = lane & 15, fq = lane >> 4;
#pragma unroll
    for (int ks = 0; ks < 4; ++ks) {
        const bf16x8 bv = *(const LAS bf16x8*)(Vt + (16 * wave + fr) * LP + 32 * ks + 8 * fq);
        const bf16x8 bn = *(const LAS bf16x8*)(Vt + (128 + fr) * LP + 32 * ks + 8 * fq);
        const bf16x8 aw = *(const LAS bf16x8*)(Kt + (16 * wave + fr) * LP + 32 * ks + 8 * fq);
        accn = MFMA16(aw, bn, accn);
#pragma unroll
        for (int nt = 0; nt < 8; ++nt) { const bf16x8 a = *(const LAS bf16x8*)(Kt + (16 * nt + fr) * LP + 32 * ks + 8 * fq); acc[nt] = MFMA16(a, bv, acc[nt]); }
    }
    float* dc = (float*)((unsigned char*)C.out + OUT_DC) + (size_t)unit * 16384 + (size_t)(16 * wave + fr) * 128 + 4 * fq;
#pragma unroll
    for (int nt = 0; nt < 8; ++nt) *(f32x4*)(dc + 16 * nt) = acc[nt];
    if (fr == 0) *(f32x4*)((float*)(C.ws + WS_DN) + (size_t)unit * 128 + 16 * wave + 4 * fq) = accn;
    __syncthreads();
}

template <int W>
__device__ __forceinline__ void pool_compute(const bf16_t* proj, size_t row0, int chunk, int g, int cp, int seg, LAS bf16_t* Ps) {
    float v[31][2];
#pragma unroll
    for (int i = 0; i < 31; ++i) {
        v[i][0] = 0.f; v[i][1] = 0.f;
        if (i >= 16 - W) {
            const int s = seg * 16 - 15 + i;
            unsigned u = 0u;
            if (chunk > 0 || s >= 0) u = *(const unsigned*)(proj + (row0 + s) * (size_t)NPROJ + C_U + g * 128 + 2 * cp);
            v[i][0] = bflo(u); v[i][1] = bfhi(u);
        }
    }
    float s0 = 0.f, s1 = 0.f;
#pragma unroll
    for (int j = 16 - W; j < 16; ++j) { s0 += v[j][0]; s1 += v[j][1]; }
#pragma unroll
    for (int i = 0; i < 16; ++i) {
        if (i > 0) { s0 += v[15 + i][0] - v[15 + i - W][0]; s1 += v[15 + i][1] - v[15 + i - W][1]; }
        const int pos = chunk * CH + seg * 16 + i;
        const float inv = 1.0f / (float)(pos + 1 < W ? pos + 1 : W);
        *(LAS unsigned*)(Ps + (seg * 16 + i) * LP + 2 * cp) = pk2(s0 * inv - v[15 + i][0], s1 * inv - v[15 + i][1]);
    }
}
__device__ __forceinline__ void pool_unit(const Ctx& C, LAS unsigned char* lds, int pu) {
    const int tid = C.tid, lane = C.lane, wave = C.wave;
    const int g = pu & 3, chunk = (pu >> 2) & 63, b = pu >> 8;
    const size_t row0 = (size_t)b * SEQ + (size_t)chunk * CH;
    LAS bf16_t* Ps = (LAS bf16_t*)lds;
    LAS bf16_t* Ws = (LAS bf16_t*)(lds + 128 * LP * 2);
    const bf16_t* proj = (const bf16_t*)(C.ws + WS_PROJ);
    const bf16_t* wsrc = (const bf16_t*)(C.ws + WS_WPOOL) + (size_t)g * 16384;
#pragma unroll
    for (int i = 0; i < 4; ++i) { const int q = tid + 512 * i, r = q >> 4, c16 = q & 15; *(LAS u32x4*)(Ws + r * LP + c16 * 8) = *(const u32x4*)(wsrc + r * 128 + c16 * 8); }
    const int cp = tid & 63, seg = tid >> 6;
    if (g == 0) pool_compute<2>(proj, row0, chunk, g, cp, seg, Ps);
    else if (g == 1) pool_compute<4>(proj, row0, chunk, g, cp, seg, Ps);
    else if (g == 2) pool_compute<8>(proj, row0, chunk, g, cp, seg, Ps);
    else pool_compute<16>(proj, row0, chunk, g, cp, seg, Ps);
    __syncthreads();
    f32x4 acc[8];
#pragma unroll
    for (int nt = 0; nt < 8; ++nt) acc[nt] = (f32x4){0.f, 0.f, 0.f, 0.f};
    const int fr = lane & 15, fq = lane >> 4;
#pragma unroll
    for (int ks = 0; ks < 4; ++ks) {
        const bf16x8 bp = *(const LAS bf16x8*)(Ps + (16 * wave + fr) * LP + 32 * ks + 8 * fq);
#pragma unroll
        for (int nt = 0; nt < 8; ++nt) { const bf16x8 a = *(const LAS bf16x8*)(Ws + (16 * nt + fr) * LP + 32 * ks + 8 * fq); acc[nt] = MFMA16(a, bp, acc[nt]); }
    }
    const size_t row = row0 + 16 * wave + fr;
    bf16_t* mix = (bf16_t*)(C.ws + WS_H);
#pragma unroll
    for (int nt = 0; nt < 8; ++nt) {
        const int col = g * 128 + 16 * nt + 4 * fq;
        const f32x4 ls = *(const f32x4*)(C.ls_pool + col);
        const u32x2 z = *(const u32x2*)(proj + row * NPROJ + C_ZP + col);
        const f32x4 y = acc[nt] * ls;
        u32x2 o; o.x = pk2(y.x * fsilu(bflo(z.x)), y.y * fsilu(bfhi(z.x))); o.y = pk2(y.z * fsilu(bflo(z.y)), y.w * fsilu(bfhi(z.y)));
        *(u32x2*)(mix + row * DM + col) = o;
    }
    __syncthreads();
}

__device__ __forceinline__ void p4_phase(const Ctx& C) {
    const float* dc = (const float*)((const unsigned char*)C.out + OUT_DC);
    bf16_t* cprev = (bf16_t*)((unsigned char*)C.out + OUT_CPREV);
    const float* mloc = (const float*)(C.ws + WS_MLOC); const float* bl = (const float*)(C.ws + WS_BL);
    const float* dn = (const float*)(C.ws + WS_DN); float* nprev = (float*)(C.ws + WS_NPREV); float* mprev = (float*)(C.ws + WS_MPREV);
    const int gt = blockIdx.x * NTHREADS + C.tid, NT = gridDim.x * NTHREADS;
    for (int e = gt; e < 16 * 8192; e += NT) {
        const int bh = e >> 13, idx = (e & 8191) * 2;
        float c0 = 0.f, c1 = 0.f, m = 0.f;
#pragma unroll 8
        for (int ch = 0; ch < NCH; ++ch) {
            const int unit = bh * NCH + ch;
            *(unsigned*)(cprev + (size_t)unit * 16384 + idx) = pk2(c0, c1);
            const f32x2 d = *(const f32x2*)(dc + (size_t)unit * 16384 + idx);
            const float ml = mloc[unit], bm = bl[unit] + m, mn = fmaxf(bm, ml), f1 = __expf(bm - mn), f2 = __expf(ml - mn);
            c0 = f1 * c0 + f2 * d.x; c1 = f1 * c1 + f2 * d.y; m = mn;
        }
    }
    for (int e = gt; e < 16 * 64; e += NT) {
        const int bh = e >> 6, idx = (e & 63) * 2;
        float n0 = 0.f, n1 = 0.f, m = 0.f;
#pragma unroll 8
        for (int ch = 0; ch < NCH; ++ch) {
            const int unit = bh * NCH + ch;
            *(f32x2*)(nprev + (size_t)unit * 128 + idx) = (f32x2){n0, n1};
            if (idx == 0) mprev[unit] = m;
            const f32x2 d = *(const f32x2*)(dn + (size_t)unit * 128 + idx);
            const float ml = mloc[unit], bm = bl[unit] + m, mn = fmaxf(bm, ml), f1 = __expf(bm - mn), f2 = __expf(ml - mn);
            n0 = f1 * n0 + f2 * d.x; n1 = f1 * n1 + f2 * d.y; m = mn;
        }
    }
}

__device__ __forceinline__ void mlstm_c_unit(const Ctx& C, LAS unsigned char* lds, int unit) {
    const int tid = C.tid, lane = C.lane, wave = C.wave;
    const int bh = unit >> 6, chunk = unit & 63, b = bh >> 2, h = bh & 3;
    const size_t row0 = (size_t)b * SEQ + (size_t)chunk * CH;
    LAS bf16_t* Ks = (LAS bf16_t*)lds;
    LAS bf16_t* Vt = (LAS bf16_t*)(lds + 128 * LP * 2);
    LAS bf16_t* Cs = (LAS bf16_t*)(lds + (128 + 144) * LP * 2);
    LAS bf16_t* Ss = (LAS bf16_t*)(lds + (128 + 288) * LP * 2);
    LAS float* arr = (LAS float*)(lds + (256 + 288) * LP * 2);
    const bf16_t* proj = (const bf16_t*)(C.ws + WS_PROJ);
    const float* G = (const float*)(C.ws + WS_GATES);
    const float mprev = ((const float*)(C.ws + WS_MPREV))[unit];
    if (wave == 0) {
        const float ig0 = G[(row0 + 2 * lane) * 8 + h], ig1 = G[(row0 + 2 * lane + 1) * 8 + h];
        const float lf0 = G[(row0 + 2 * lane) * 8 + 4 + h], lf1 = G[(row0 + 2 * lane + 1) * 8 + 4 + h];
        float incl = lf0 + lf1;
#pragma unroll
        for (int o = 1; o < 64; o <<= 1) { const float t = __shfl_up(incl, o); if (lane >= o) incl += t; }
        const float b1 = incl, b0 = incl - lf1, a0 = ig0 - b0, a1 = ig1 - b1;
        float mx = fmaxf(a0, a1);
#pragma unroll
        for (int o = 1; o < 64; o <<= 1) { const float t = __shfl_up(mx, o); if (lane >= o) mx = fmaxf(mx, t); }
        float ex = __shfl_up(mx, 1); if (lane == 0) ex = -INFINITY;
        const float M0 = fmaxf(mprev, fmaxf(ex, a0)), M1 = fmaxf(mprev, mx);
        arr[2 * lane] = a0; arr[2 * lane + 1] = a1; arr[128 + 2 * lane] = M0; arr[128 + 2 * lane + 1] = M1; arr[256 + 2 * lane] = b0; arr[256 + 2 * lane + 1] = b1;
    }
    {
        const bf16_t* kc = (const bf16_t*)(C.ws + WS_KC) + row0 * 512 + h * 128;
        const bf16_t* cp = (const bf16_t*)((const unsigned char*)C.out + OUT_CPREV) + (size_t)unit * 16384;
#pragma unroll
        for (int i = 0; i < 4; ++i) { const int q = tid + 512 * i, r = q >> 4, c16 = q & 15;
            *(LAS u32x4*)(Ks + r * LP + c16 * 8) = *(const u32x4*)(kc + (size_t)r * 512 + c16 * 8);
            *(LAS u32x4*)(Cs + r * LP + c16 * 8) = *(const u32x4*)(cp + r * 128 + c16 * 8); }
        const int vp = tid & 63, seg = tid >> 6;
        unsigned vraw[16];
#pragma unroll
        for (int i = 0; i < 16; ++i) vraw[i] = *(const unsigned*)(proj + (row0 + seg * 16 + i) * (size_t)NPROJ + C_V + h * 128 + 2 * vp);
#pragma unroll
        for (int e = 0; e < 2; ++e) {
            u32x4 lo, hi;
            if (e == 0) {
                lo.x = (vraw[0] & 0xffffu) | (vraw[1] << 16); lo.y = (vraw[2] & 0xffffu) | (vraw[3] << 16); lo.z = (vraw[4] & 0xffffu) | (vraw[5] << 16); lo.w = (vraw[6] & 0xffffu) | (vraw[7] << 16);
                hi.x = (vraw[8] & 0xffffu) | (vraw[9] << 16); hi.y = (vraw[10] & 0xffffu) | (vraw[11] << 16); hi.z = (vraw[12] & 0xffffu) | (vraw[13] << 16); hi.w = (vraw[14] & 0xffffu) | (vraw[15] << 16);
            } else {
                lo.x = (vraw[0] >> 16) | (vraw[1] & 0xffff0000u); lo.y = (vraw[2] >> 16) | (vraw[3] & 0xffff0000u); lo.z = (vraw[4] >> 16) | (vraw[5] & 0xffff0000u); lo.w = (vraw[6] >> 16) | (vraw[7] & 0xffff0000u);
                hi.x = (vraw[8] >> 16) | (vraw[9] & 0xffff0000u); hi.y = (vraw[10] >> 16) | (vraw[11] & 0xffff0000u); hi.z = (vraw[12] >> 16) | (vraw[13] & 0xffff0000u); hi.w = (vraw[14] >> 16) | (vraw[15] & 0xffff0000u);
            }
            LAS u32x4* p = (LAS u32x4*)(Vt + (2 * vp + e) * LP + seg * 16); p[0] = lo; p[1] = hi;
        }
        const int r = 128 + (tid >> 5), s4 = (tid & 31) * 4;
        u32x2 zv, zc; zv.x = 0u; zv.y = 0u; zc = zv;
        if (r == 128) { zv.x = 0x3f803f80u; zv.y = 0x3f803f80u;
            const f32x4 nn = *(const f32x4*)((const float*)(C.ws + WS_NPREV) + (size_t)unit * 128 + s4); zc.x = pk2(nn.x, nn.y); zc.y = pk2(nn.z, nn.w); }
        *(LAS u32x2*)(Vt + r * LP + s4) = zv; *(LAS u32x2*)(Cs + r * LP + s4) = zc;
    }
    const int fr = lane & 15, fq = lane >> 4;
    const size_t trow = row0 + 16 * wave + fr;
    bf16x8 qf[4];
    { const bf16_t* qp = (const bf16_t*)(C.ws + WS_QC) + trow * 512 + h * 128 + 8 * fq;
#pragma unroll
      for (int ks = 0; ks < 4; ++ks) qf[ks] = *(const bf16x8*)(qp + 32 * ks); }
    __syncthreads();
    const float Mt = arr[128 + 16 * wave + fr], btv = arr[256 + 16 * wave + fr];
#pragma unroll
    for (int nt = 0; nt < 8; ++nt) {
        if (nt <= (wave | 1)) {
            u32x2 o; o.x = 0u; o.y = 0u;
            if (nt <= wave) {
                f32x4 s = (f32x4){0.f, 0.f, 0.f, 0.f};
#pragma unroll
                for (int ks = 0; ks < 4; ++ks) { const bf16x8 a = *(const LAS bf16x8*)(Ks + (16 * nt + fr) * LP + 32 * ks + 8 * fq); s = MFMA16(a, qf[ks], s); }
                const f32x4 a4 = *(const LAS f32x4*)(arr + 16 * nt + 4 * fq);
                float v[4];
#pragma unroll
                for (int r = 0; r < 4; ++r) { const int sidx = 16 * nt + 4 * fq + r; v[r] = (sidx <= 16 * wave + fr) ? s[r] * __expf(a4[r] - Mt) : 0.f; }
                o.x = pk2(v[0], v[1]); o.y = pk2(v[2], v[3]);
            }
            *(LAS u32x2*)(Ss + (16 * wave + fr) * LP + 16 * nt + 4 * fq) = o;
        }
    }
    LDS_WAIT();
    f32x4 acc1[9], acc2[9];
#pragma unroll
    for (int nt = 0; nt < 9; ++nt) { acc1[nt] = (f32x4){0.f, 0.f, 0.f, 0.f}; acc2[nt] = (f32x4){0.f, 0.f, 0.f, 0.f}; }
#pragma unroll
    for (int ks = 0; ks < 4; ++ks) {
        if (ks <= (wave >> 1)) {
            const bf16x8 sf = *(const LAS bf16x8*)(Ss + (16 * wave + fr) * LP + 32 * ks + 8 * fq);
#pragma unroll
            for (int nt = 0; nt < 9; ++nt) { const bf16x8 a = *(const LAS bf16x8*)(Vt + (16 * nt + fr) * LP + 32 * ks + 8 * fq); acc1[nt] = MFMA16(a, sf, acc1[nt]); }
        }
    }
#pragma unroll
    for (int ks = 0; ks < 4; ++ks) {
#pragma unroll
        for (int nt = 0; nt < 9; ++nt) { const bf16x8 a = *(const LAS bf16x8*)(Cs + (16 * nt + fr) * LP + 32 * ks + 8 * fq); acc2[nt] = MFMA16(a, qf[ks], acc2[nt]); }
    }
    const float inter = __expf(mprev - Mt), mt = btv + Mt;
    float den = acc1[8][0] + inter * acc2[8][0];
    den = __shfl(den, fr);
    const float inv = 1.0f / fmaxf(fabsf(den), __expf(-mt));
    float ss = 0.f;
#pragma unroll
    for (int nt = 0; nt < 8; ++nt) { acc1[nt] = (acc1[nt] + acc2[nt] * inter) * inv; ss += (acc1[nt].x * acc1[nt].x + acc1[nt].y * acc1[nt].y) + (acc1[nt].z * acc1[nt].z + acc1[nt].w * acc1[nt].w); }
    ss += __shfl_xor(ss, 16); ss += __shfl_xor(ss, 32);
    const float rstd = 1.0f / sqrtf(ss * (1.0f / DH) + EPS);
    bf16_t* mix = (bf16_t*)(C.ws + WS_H);
#pragma unroll
    for (int nt = 0; nt < 8; ++nt) {
        const int col = h * 128 + 16 * nt + 4 * fq;
        const f32x4 g4 = *(const f32x4*)(C.mh_norm_g + col);
        const u32x2 o4 = *(const u32x2*)(proj + trow * NPROJ + C_O + col);
        const u32x2 z4 = *(const u32x2*)(proj + trow * NPROJ + C_ZM + col);
        const f32x4 y = acc1[nt] * rstd * g4;
        u32x2 o;
        o.x = pk2(y.x * fsigm(bflo(o4.x)) * fsilu(bflo(z4.x)), y.y * fsigm(bfhi(o4.x)) * fsilu(bfhi(z4.x)));
        o.y = pk2(y.z * fsigm(bflo(o4.y)) * fsilu(bflo(z4.y)), y.w * fsigm(bfhi(o4.y)) * fsilu(bfhi(z4.y)));
        *(u32x2*)(mix + trow * DM + 512 + col) = o;
    }
    __syncthreads();
}

struct EpiResGate {
    static constexpr bool PERM = false, AFTER_DRAIN = false;
    const float* x; float* out; const float* b_ada; const unsigned char* ws;
    __device__ __forceinline__ void operator()(const f32x4 (&acc)[2][2][4][2], const pg8::Unit& u, int wr, int wc, int fr, int fq) const {
        const int row0 = u.pm * 256 + wr * 64 + fr, col0 = u.pn * 256 + wc * 32 + 4 * fq, b = (u.pm * 256) / SEQ;
        f32x4 gv[2][2];
#pragma unroll
        for (int bj = 0; bj < 2; ++bj)
#pragma unroll
            for (int n = 0; n < 2; ++n) gv[bj][n] = mod4(b_ada, ws, b, 2048 + col0 + bj * 128 + n * 16);
#pragma unroll
        for (int ai = 0; ai < 2; ++ai)
#pragma unroll
            for (int m = 0; m < 4; ++m) {
                const size_t off = (size_t)(row0 + ai * 128 + m * 16) * DM + col0;
#pragma unroll
                for (int bj = 0; bj < 2; ++bj)
#pragma unroll
                    for (int n = 0; n < 2; ++n) { const f32x4 xv = *(const f32x4*)(x + off + bj * 128 + n * 16); *(f32x4*)(out + off + bj * 128 + n * 16) = xv + gv[bj][n] * acc[ai][bj][m][n]; }
            }
    }
};

__device__ __forceinline__ void p7_phase(const Ctx& C) {
    const int gw = blockIdx.x * NWAVES + C.wave, NGW = gridDim.x * NWAVES, lane = C.lane;
    f32x4 fg[4];
#pragma unroll
    for (int j = 0; j < 4; ++j) fg[j] = *(const f32x4*)(C.final_g + 4 * lane + 256 * j);
    for (int m = gw; m < MROWS; m += NGW) {
        f32x4* xr = (f32x4*)(C.out + (size_t)m * DM) + lane;
        f32x4 v[4]; float ss = 0.f;
#pragma unroll
        for (int j = 0; j < 4; ++j) { v[j] = xr[64 * j]; ss += (v[j].x * v[j].x + v[j].y * v[j].y) + (v[j].z * v[j].z + v[j].w * v[j].w); }
        const float rstd = 1.0f / sqrtf(wave_sum(ss) * (1.0f / DM) + EPS);
#pragma unroll
        for (int j = 0; j < 4; ++j) xr[64 * j] = v[j] * rstd * fg[j];
    }
}

__global__ void __launch_bounds__(NTHREADS, 2) fwd_megakernel(Args args) {
    extern __shared__ __attribute__((aligned(16))) unsigned char lds_raw[];
    LAS unsigned char* lds = (LAS unsigned char*)lds_raw;
    cg::grid_group grid = cg::this_grid();
    Ctx C;
    C.x = args.in[0]; C.c = args.in[1]; C.norm_g = args.in[2]; C.w_ada = args.in[3]; C.b_ada = args.in[4]; C.w_in = args.in[5]; C.b_gates = args.in[6];
    C.conv_w = args.in[7]; C.conv_b = args.in[8]; C.w_pool = args.in[9]; C.ls_pool = args.in[10]; C.mh_norm_g = args.in[11]; C.w_out = args.in[12]; C.final_g = args.in[13];
    C.out = args.out; C.ws = args.ws;
    C.tid = threadIdx.x; C.lane = C.tid & 63; C.wave = __builtin_amdgcn_readfirstlane(C.tid >> 6);
    const int lo = args.ph_lo, hi = args.ph_hi;
#define IN(k) (lo <= (k) && (k) < hi)
#define SEAM(k) do { if (IN(k) && IN((k) + 1)) grid.sync(); } while (0)
    if (IN(0)) p0_phase(C, lds);
    SEAM(0);
    if (IN(1)) p1_phase(C);
    SEAM(1);
    if (IN(2)) {
        pg8::Gemm g{(const bf16_t*)(C.ws + WS_H), (const bf16_t*)(C.ws + WS_WIN), MROWS, NPROJ, DM};
        pg8::StaticOrder S; S.init(MROWS, NPROJ, (int)gridDim.x, (int)blockIdx.x);
        pg8::EpiBf16<0> E{(bf16_t*)(C.ws + WS_PROJ), NPROJ, nullptr, 0, 0};
        pg8::gemm_phase<pg8::EpiBf16<0>, pg8::StaticOrder>(lds, g, S, E, nullptr);
        __syncthreads();
    }
    SEAM(2);
    if (IN(3)) {
        for (int u = blockIdx.x; u < 2 * NUNIT; u += gridDim.x) { if (u < NUNIT) mlstm_a_unit(C, lds, u); else pool_unit(C, lds, u - NUNIT); }
    }
    SEAM(3);
    if (IN(4)) p4_phase(C);
    SEAM(4);
    if (IN(5)) { for (int u = blockIdx.x; u < NUNIT; u += gridDim.x) mlstm_c_unit(C, lds, u); }
    SEAM(5);
    if (IN(6)) {
        pg8::Gemm g{(const bf16_t*)(C.ws + WS_H), (const bf16_t*)(C.ws + WS_WOUT), MROWS, DM, DM};
        pg8::StaticOrder S; S.init(MROWS, DM, (int)gridDim.x, (int)blockIdx.x);
        EpiResGate E{C.x, C.out, C.b_ada, C.ws};
        pg8::gemm_phase<EpiResGate, pg8::StaticOrder>(lds, g, S, E, nullptr);
        __syncthreads();
    }
    SEAM(6);
    if (IN(7)) p7_phase(C);
#undef IN
#undef SEAM
}

#ifndef MK_N_LAUNCHES
#define MK_N_LAUNCHES 1
#endif
extern "C" void kernel_launch(void* const* d_in, const int* in_sizes, int n_in, void* d_out, int out_size, void* d_ws, size_t ws_size, hipStream_t stream) {
    static int grid = 0;
    if (grid == 0) {
        if (n_in != 14 || out_size != MROWS * DM || ws_size < WS_END) { fprintf(stderr, "kernel_launch: unexpected shapes (n_in %d out %d ws %zu need %zu)\n", n_in, out_size, ws_size, (size_t)WS_END); grid = -1; return; }
        int dev = 0, cus = 0, per_cu = 0;
        hipGetDevice(&dev);
        hipDeviceGetAttribute(&cus, hipDeviceAttributeMultiprocessorCount, dev);
        if (hipFuncSetAttribute((const void*)fwd_megakernel, hipFuncAttributeMaxDynamicSharedMemorySize, LDS_BYTES) != hipSuccess) { fprintf(stderr, "kernel_launch: hipFuncSetAttribute failed\n"); grid = -1; return; }
        if (hipOccupancyMaxActiveBlocksPerMultiprocessor(&per_cu, (const void*)fwd_megakernel, NTHREADS, LDS_BYTES) != hipSuccess || per_cu < 1) { fprintf(stderr, "kernel_launch: occupancy query says %d\n", per_cu); per_cu = 1; }
        (void)hipGetLastError();
        grid = cus * 1;
        if (grid != 256) fprintf(stderr, "kernel_launch: note: %d CUs\n", cus);
    }
    if (grid < 0) return;
    Args a{};
    for (int i = 0; i < 14; ++i) a.in[i] = (const float*)d_in[i];
    a.out = (float*)d_out; a.ws = (unsigned char*)d_ws;
#if MK_N_LAUNCHES == 1
    a.ph_lo = 0; a.ph_hi = 8;
    void* kargs[] = {&a};
    hipError_t e = hipLaunchCooperativeKernel((const void*)fwd_megakernel, dim3(grid), dim3(NTHREADS), kargs, LDS_BYTES, stream);
    if (e != hipSuccess) fprintf(stderr, "kernel_launch: cooperative launch failed: %s (grid %d)\n", hipGetErrorString(e), grid);
#else
    for (int p = 0; p < 8; ++p) { a.ph_lo = p; a.ph_hi = p + 1; hipLaunchKernelGGL(fwd_megakernel, dim3(grid), dim3(NTHREADS), LDS_BYTES, stream, a); }
#endif
}
```

```cpp
#include <hip/hip_runtime.h>
#include <hip/hip_cooperative_groups.h>
#include <cstdio>
namespace cg = cooperative_groups;
namespace pg8 {
#define PG8_LAS __attribute__((address_space(3)))
typedef unsigned short bf16_t;
typedef short bf16x8 __attribute__((ext_vector_type(8)));
typedef float f32x4 __attribute__((ext_vector_type(4)));
typedef unsigned u32x4 __attribute__((ext_vector_type(4)));
constexpr int BM = 256, BK = 64, HALF = 128, HTB = HALF * BK * 2  , STAGE_BYTES = 8 * HTB, NXCD = 8, WGM = 8;

__host__ __device__ __forceinline__ int lds_byte(int r, int c) { const int st = (r >> 4) * 2 + (c >> 5), rr = r & 15, cc = c & 31, ob = rr * 64 + cc * 2; return st * 1024 + (ob ^ (((ob >> 9) & 1) << 5)); }
__host__ __device__ __forceinline__ void stage_rc(int b, int& R, int& C) { const int st = b / 1024, sb = b % 1024, swz = sb ^ (((sb >> 9) & 1) << 5); R = (st >> 1) * 16 + swz / 64; C = (st & 1) * 32 + (swz % 64) / 2; }
__host__ __device__ __forceinline__ int perm32(int rho) { const int n = rho >> 4, i = rho & 15; return 8 * (i >> 2) + 4 * n + (i & 3); }

struct Unit { int pm, pn; };
struct Gemm { const bf16_t* A; const bf16_t* Bt; int M, N, K; };

struct StaticOrder {
    int nM, nN, nwg, G, c;
    __host__ __device__ void init(int M, int N, int G_, int c_) { nM = M / BM; nN = N / BM; nwg = nM * nN; G = G_; c = c_; }
    __host__ __device__ bool next(int i, Unit& u) const {
        const long L = (long)i * G + c; if (L >= nwg) return false;
        int wgid = (int)L; { const int q = nwg / NXCD, r = nwg % NXCD, xcd = wgid % NXCD, off = wgid / NXCD; wgid = (xcd < r ? xcd * (q + 1) : r * (q + 1) + (xcd - r) * q) + off; }
        const int nig = WGM * nN, gid = wgid / nig, fm = gid * WGM, gsz = (nM - fm) < WGM ? (nM - fm) : WGM;
        u.pm = fm + ((wgid % nig) % gsz); u.pn = (wgid % nig) / gsz; return true;
    }
    __device__ __forceinline__ void a_ready(const Unit&) const {}
    __device__ __forceinline__ void done(const Unit&) const {}
};
__device__ __forceinline__ unsigned cvt_pk_bf16(float lo, float hi) { unsigned r; asm volatile("v_cvt_pk_bf16_f32 %0, %1, %2" : "=v"(r) : "v"(lo), "v"(hi)); return r; }
typedef float f32x2 __attribute__((ext_vector_type(2)));
__device__ __forceinline__ f32x2 gelu_pk(f32x2 v) {
    const f32x2 av = __builtin_elementwise_abs(v), d = av * 0.2316418882f + 1.0f;
    f32x2 t; t.x = __builtin_amdgcn_rcpf(d.x); t.y = __builtin_amdgcn_rcpf(d.y);
    f32x2 q = t * 0.5307027145f + (-0.7265760135f); q = q * t + 0.7107068705f; q = q * t + (-0.142248368f); q = q * t + 0.127414796f; q = q * t;
    const f32x2 s = (v * v) * (-0.72134752044f);
    f32x2 e; e.x = __builtin_amdgcn_exp2f(s.x); e.y = __builtin_amdgcn_exp2f(s.y);
    const f32x2 m = v * (q * e), r = v - m;
    f32x2 o; o.x = v.x < 0.f ? m.x : r.x; o.y = v.y < 0.f ? m.y : r.y; return o;
}

struct EpiF32 {
    static constexpr bool PERM = false, AFTER_DRAIN = false;
    float* C; int ldc; const float* bias;
    __device__ __forceinline__ void operator()(const f32x4 (&acc)[2][2][4][2], const Unit& u, int wr, int wc, int fr, int fq) const {
        const int row0 = u.pm * BM + wr * 64 + fr, col0 = u.pn * BM + wc * 32 + 4 * fq;
        f32x4 bv[2][2];
#pragma unroll
        for (int bj = 0; bj < 2; ++bj)
#pragma unroll
            for (int n = 0; n < 2; ++n) bv[bj][n] = bias ? *(const f32x4*)(bias + col0 + bj * HALF + n * 16) : (f32x4){0.f, 0.f, 0.f, 0.f};
#pragma unroll
        for (int ai = 0; ai < 2; ++ai)
#pragma unroll
            for (int m = 0; m < 4; ++m) { float* rowp = C + (size_t)(row0 + ai * HALF + m * 16) * ldc + col0;
#pragma unroll
                for (int bj = 0; bj < 2; ++bj)
#pragma unroll
                    for (int n = 0; n < 2; ++n) *(f32x4*)(rowp + bj * HALF + n * 16) = acc[ai][bj][m][n] + bv[bj][n]; }
    }
};
template <int ACT  > struct EpiBf16 {
    static constexpr bool PERM = true, AFTER_DRAIN = false;
    bf16_t* O; int ldc; const float* bias; int split_cols; size_t split_stride;
    __device__ __forceinline__ void operator()(const f32x4 (&acc)[2][2][4][2], const Unit& u, int wr, int wc, int fr, int fq) const {
        const int row0 = u.pm * BM + wr * 64 + fr; int colt = u.pn * BM; bf16_t* base = O;
        if (split_cols) { const int t = colt / split_cols; base += (size_t)t * split_stride; colt -= t * split_cols; }
        const int col0 = colt + wc * 32 + 8 * fq, bcol0 = u.pn * BM + wc * 32 + 8 * fq;
        f32x4 bv[2][2];
#pragma unroll
        for (int bj = 0; bj < 2; ++bj)
#pragma unroll
            for (int n = 0; n < 2; ++n) bv[bj][n] = bias ? *(const f32x4*)(bias + bcol0 + bj * HALF + 4 * n) : (f32x4){0.f, 0.f, 0.f, 0.f};
#pragma unroll
        for (int ai = 0; ai < 2; ++ai)
#pragma unroll
            for (int m = 0; m < 4; ++m) { bf16_t* rowp = base + (size_t)(row0 + ai * HALF + m * 16) * ldc + col0;
#pragma unroll
                for (int bj = 0; bj < 2; ++bj) { f32x4 v0 = acc[ai][bj][m][0] + bv[bj][0], v1 = acc[ai][bj][m][1] + bv[bj][1];
                    if (ACT == 1) { f32x2 a = gelu_pk((f32x2){v0[0], v0[1]}), b = gelu_pk((f32x2){v0[2], v0[3]}), c = gelu_pk((f32x2){v1[0], v1[1]}), d = gelu_pk((f32x2){v1[2], v1[3]});
                        v0 = (f32x4){a.x, a.y, b.x, b.y}; v1 = (f32x4){c.x, c.y, d.x, d.y}; }
                    if (ACT == 2) {
#pragma unroll
                        for (int j = 0; j < 4; ++j) { v0[j] = 0.5f * v0[j] * (1.0f + erff(v0[j] * 0.70710678f)); v1[j] = 0.5f * v1[j] * (1.0f + erff(v1[j] * 0.70710678f)); } }
                    u32x4 w; w.x = cvt_pk_bf16(v0[0], v0[1]); w.y = cvt_pk_bf16(v0[2], v0[3]); w.z = cvt_pk_bf16(v1[0], v1[1]); w.w = cvt_pk_bf16(v1[2], v1[3]);
                    *(u32x4*)(rowp + bj * HALF) = w; } }
    }
};
template <class Epi, class Sched, bool STAMP = false>
__device__ __forceinline__ void gemm_phase(PG8_LAS unsigned char* lds, const Gemm g, const Sched& S, const Epi& E, unsigned long long* stamps) {
    const int tid = threadIdx.x, wid = __builtin_amdgcn_readfirstlane(tid >> 6), lane = tid & 63, wr = wid >> 2, wc = wid & 3, fr = lane & 15, fq = lane >> 4;
    const int K = g.K, nt = K / BK;
    int ts_lo = 0, ts_hi = 0, nts = 0; const unsigned long long rt_entry = STAMP ? (unsigned long long)wall_clock64() : 0ull;
#define PG8_STAMP() do { if (STAMP && wid == 0 && nts < 64) { const unsigned long long _c = (unsigned long long)clock64(); \
        ts_lo = (lane == nts) ? (int)(unsigned)_c : ts_lo; ts_hi = (lane == nts) ? (int)(unsigned)(_c >> 32) : ts_hi; ++nts; } } while (0)
    PG8_STAMP();
    unsigned voffA[2], voffB[2];
#pragma unroll
    for (int i = 0; i < 2; ++i) { int R, C; stage_rc(tid * 16 + i * 8192, R, C); const int Rb = Epi::PERM ? ((R & ~31) + perm32(R & 31)) : R;
        voffA[i] = (unsigned)(R * K + C) * 2u; voffB[i] = (unsigned)(Rb * K + C) * 2u; }
    const size_t kstep = (size_t)(BK * 2);
    const size_t hstep = (size_t)HALF * K * 2;
    const size_t tstep = 2 * hstep;
    const unsigned ldsw = (unsigned)wid * 1024u;
    const int aoff = lds_byte(wr * 64 + fr, fq * 8), boff = lds_byte(wc * 32 + fr, fq * 8);
#define PG8_SA(b, h) (((b) * 2 + (h)) * HTB)
#define PG8_SB(b, h) ((4 + (b) * 2 + (h)) * HTB)
#define PG8_STAGE(bufoff, gbase, voff) do { _Pragma("unroll") for (int _i = 0; _i < 2; ++_i) \
        __builtin_amdgcn_global_load_lds((const unsigned*)((const char*)(gbase) + (voff)[_i]), (PG8_LAS unsigned*)(lds + (bufoff) + ldsw + _i * 8192), 16, 0, 0); } while (0)
#define PG8_LDA(dst, b, h) do { _Pragma("unroll") for (int m = 0; m < 4; ++m) _Pragma("unroll") for (int k = 0; k < 2; ++k) dst[m][k] = *(const PG8_LAS bf16x8*)(lds + PG8_SA(b, h) + aoff + m * 2048 + k * 1024); } while (0)
#define PG8_LDB(dst, b, h) do { _Pragma("unroll") for (int n = 0; n < 2; ++n) _Pragma("unroll") for (int k = 0; k < 2; ++k) dst[n][k] = *(const PG8_LAS bf16x8*)(lds + PG8_SB(b, h) + boff + n * 2048 + k * 1024); } while (0)
#define PG8_MMA(ai, bj, At, Bt) do { __builtin_amdgcn_s_setprio(1); _Pragma("unroll") for (int m = 0; m < 4; ++m) _Pragma("unroll") for (int n = 0; n < 2; ++n) _Pragma("unroll") for (int k = 0; k < 2; ++k) \
        acc[ai][bj][m][n] = __builtin_amdgcn_mfma_f32_16x16x32_bf16(Bt[n][k], At[m][k], acc[ai][bj][m][n], 0, 0, 0); __builtin_amdgcn_s_setprio(0); } while (0)
#define PG8_WAIT_V(n) asm volatile("s_waitcnt vmcnt(" #n ")" ::: "memory")
#define PG8_WAIT_L(n) asm volatile("s_waitcnt lgkmcnt(" #n ")" ::: "memory")
#define PG8_BAR __builtin_amdgcn_s_barrier()
#define PG8_SCHED __builtin_amdgcn_sched_barrier(0)
    Unit cur, nxt; int ui = 0;
    if (!S.next(0, cur)) return;
    f32x4 acc[2][2][4][2];
#pragma unroll
    for (int a = 0; a < 2; ++a)
#pragma unroll
        for (int b = 0; b < 2; ++b)
#pragma unroll
            for (int m = 0; m < 4; ++m)
#pragma unroll
                for (int n = 0; n < 2; ++n) acc[a][b][m][n] = (f32x4){0.f, 0.f, 0.f, 0.f};
    bf16x8 At[4][2], B0[2][2], B1[2][2];
    const char* cA = (const char*)g.A + (size_t)cur.pm * tstep; const char* cB = (const char*)g.Bt + (size_t)cur.pn * tstep;
    S.a_ready(cur);
    PG8_STAGE(PG8_SB(0, 0), cB, voffB); PG8_STAGE(PG8_SA(0, 0), cA, voffA); PG8_STAGE(PG8_SB(0, 1), cB + hstep, voffB); PG8_STAGE(PG8_SA(0, 1), cA + hstep, voffA);
    if (wr == 1) PG8_BAR;
    PG8_WAIT_V(4); PG8_BAR;
    PG8_STAGE(PG8_SB(1, 0), cB + kstep, voffB); PG8_STAGE(PG8_SA(1, 0), cA + kstep, voffA); PG8_STAGE(PG8_SB(1, 1), cB + hstep + kstep, voffB);
    PG8_WAIT_V(6); PG8_BAR;
    PG8_STAMP();
    for (;;) {
        const bool has_next = S.next(ui + 1, nxt);
        const char* nA = has_next ? (const char*)g.A + (size_t)nxt.pm * tstep : cA; const char* nB = has_next ? (const char*)g.Bt + (size_t)nxt.pn * tstep : cB;
        for (int t = 0; t < nt; t += 2) {
            const bool last = (t == nt - 2);
            const char* a1 = cA + (size_t)(t + 1) * kstep;
            const char* a2 = last ? nA : cA + (size_t)(t + 2) * kstep; const char* b2 = last ? nB : cB + (size_t)(t + 2) * kstep;
            const char* a3 = a2 + kstep; const char* b3 = b2 + kstep;
            if (last && has_next) S.a_ready(nxt);
            PG8_LDB(B0, 0, 0); PG8_SCHED; PG8_LDA(At, 0, 0); PG8_STAGE(PG8_SA(1, 1), a1 + hstep, voffA);
            PG8_WAIT_L(8); PG8_BAR; PG8_WAIT_L(0); PG8_MMA(0, 0, At, B0); PG8_BAR; PG8_SCHED;
            PG8_LDB(B1, 0, 1); PG8_STAGE(PG8_SB(0, 0), b2, voffB);
            PG8_BAR; PG8_WAIT_L(0); PG8_MMA(0, 1, At, B1); PG8_BAR;
            PG8_LDA(At, 0, 1); PG8_STAGE(PG8_SA(0, 0), a2, voffA);
            PG8_BAR; PG8_WAIT_L(0); PG8_MMA(1, 0, At, B0); PG8_BAR; PG8_SCHED;
            PG8_STAGE(PG8_SB(0, 1), b2 + hstep, voffB);
            PG8_WAIT_V(6); PG8_BAR; PG8_MMA(1, 1, At, B1); PG8_BAR;
            PG8_LDB(B0, 1, 0); PG8_SCHED; PG8_LDA(At, 1, 0); PG8_STAGE(PG8_SA(0, 1), a2 + hstep, voffA);
            PG8_WAIT_L(8); PG8_BAR; PG8_WAIT_L(0); PG8_MMA(0, 0, At, B0); PG8_BAR; PG8_SCHED;
            PG8_LDB(B1, 1, 1); PG8_STAGE(PG8_SB(1, 0), b3, voffB);
            PG8_BAR; PG8_WAIT_L(0); PG8_MMA(0, 1, At, B1); PG8_BAR;
            PG8_LDA(At, 1, 1); PG8_STAGE(PG8_SA(1, 0), a3, voffA);
            PG8_BAR; PG8_WAIT_L(0); PG8_MMA(1, 0, At, B0); PG8_BAR; PG8_SCHED;
            PG8_STAGE(PG8_SB(1, 1), b3 + hstep, voffB);
            PG8_WAIT_V(6); PG8_BAR; PG8_MMA(1, 1, At, B1); PG8_BAR;
        }
        PG8_STAMP();
        if constexpr (!Epi::AFTER_DRAIN) { E(acc, cur, wr, wc, fr, fq); S.done(cur); }
        PG8_STAMP();
        if (!has_next) break;
#pragma unroll
        for (int a = 0; a < 2; ++a)
#pragma unroll
            for (int b = 0; b < 2; ++b)
#pragma unroll
                for (int m = 0; m < 4; ++m)
#pragma unroll
                    for (int n = 0; n < 2; ++n) acc[a][b][m][n] = (f32x4){0.f, 0.f, 0.f, 0.f};
        cur = nxt; cA = nA; cB = nB; ++ui;
    }
    PG8_WAIT_V(0);
    if (wr == 0) PG8_BAR;
    PG8_BAR;
    if constexpr (Epi::AFTER_DRAIN) { E.fused(acc, cur, wr, wc, fr, fq, lds, wid, lane); S.done(cur); }
    PG8_STAMP();
    if (STAMP && wid == 0) { stamps[lane] = lane < nts ? (((unsigned long long)(unsigned)ts_hi << 32) | (unsigned)ts_lo) : 0ull;
        if (lane == 62) stamps[62] = rt_entry; if (lane == 63) stamps[63] = (unsigned long long)wall_clock64(); }
#undef PG8_STAMP
#undef PG8_SA
#undef PG8_SB
#undef PG8_STAGE
#undef PG8_LDA
#undef PG8_LDB
#undef PG8_MMA
#undef PG8_WAIT_V
#undef PG8_WAIT_L
#undef PG8_BAR
#undef PG8_SCHED
}
}

#define LAS __attribute__((address_space(3)))
typedef unsigned short bf16_t;
typedef short bf16x8 __attribute__((ext_vector_type(8)));
typedef float f32x4 __attribute__((ext_vector_type(4)));
typedef float f32x2 __attribute__((ext_vector_type(2)));
typedef unsigned u32x4 __attribute__((ext_vector_type(4)));
typedef unsigned u32x2 __attribute__((ext_vector_type(2)));

constexpr int NB = 4, SEQ = 8192, DM = 1024, MROWS = NB * SEQ;
constexpr int NPROJ = 3584, LDW = 3592;
constexpr int C_U = 0, C_ZP = 512, C_Q = 1024, C_K = 1536, C_V = 2048, C_O = 2560, C_ZM = 3072, C_G = 3584;
constexpr int NH = 4, DH = 128, CH = 128, NCH = SEQ / CH, NUNIT = NB * NH * NCH;
constexpr float EPS = 1e-6f;
constexpr int NTHREADS = 512, NWAVES = 8;
constexpr int LP = 136;
constexpr size_t WS_WIN = 0;
constexpr size_t WS_WOUT = WS_WIN + (size_t)NPROJ * DM * 2;
constexpr size_t WS_WPOOL = WS_WOUT + (size_t)DM * DM * 2;
constexpr size_t WS_MODP = WS_WPOOL + (size_t)4 * 128 * 128 * 2;
constexpr size_t WS_GATES = WS_MODP + (size_t)4 * NB * 3072 * 4;
constexpr size_t WS_DN = WS_GATES + (size_t)MROWS * 8 * 4;
constexpr size_t WS_NPREV = WS_DN + (size_t)NUNIT * 128 * 4;
constexpr size_t WS_MLOC = WS_NPREV + (size_t)NUNIT * 128 * 4;
constexpr size_t WS_BL = WS_MLOC + (size_t)NUNIT * 4;
constexpr size_t WS_MPREV = WS_BL + (size_t)NUNIT * 4;
constexpr size_t WS_WGT = WS_MPREV + (size_t)NUNIT * 4;
constexpr size_t WS_H = WS_WGT + 32 * 64 * 16;
constexpr size_t WS_PROJ = WS_H + (size_t)MROWS * DM * 2;
constexpr size_t WS_QC = WS_PROJ + (size_t)MROWS * NPROJ * 2;
constexpr size_t WS_KC = WS_QC + (size_t)MROWS * 512 * 2;
constexpr size_t WS_END = WS_KC + (size_t)MROWS * 512 * 2;
constexpr size_t OUT_DC = 0, OUT_CPREV = (size_t)NUNIT * 16384 * 4;
constexpr int LDS_BYTES = 150 * 1024;

__device__ constexpr int REPS[8] = {1, 1, 1, 1, 1, 1, 1, 1};
struct Args { const float* in[14]; float* out; unsigned char* ws; int ph_lo, ph_hi; };

struct Ctx {
    const float *x, *c, *norm_g, *w_ada, *b_ada, *w_in, *b_gates, *conv_w, *conv_b, *w_pool, *ls_pool, *mh_norm_g, *w_out, *final_g;
    float* out; unsigned char* ws;
    int tid, lane, wave;
};

__device__ __forceinline__ unsigned pk2(float lo, float hi) { unsigned r; asm volatile("v_cvt_pk_bf16_f32 %0, %1, %2" : "=v"(r) : "v"(lo), "v"(hi)); return r; }
__device__ __forceinline__ float bflo(unsigned u) { return __uint_as_float(u << 16); }
__device__ __forceinline__ float bfhi(unsigned u) { return __uint_as_float(u & 0xffff0000u); }
__device__ __forceinline__ float fsilu(float v) { return v * __builtin_amdgcn_rcpf(1.0f + __expf(-v)); }
__device__ __forceinline__ float fsigm(float v) { return __builtin_amdgcn_rcpf(1.0f + __expf(-v)); }
__device__ __forceinline__ float wave_sum(float v) {
#pragma unroll
    for (int o = 1; o < 64; o <<= 1) v += __shfl_xor(v, o);
    return v;
}
__device__ __forceinline__ float wave_max(float v) {
#pragma unroll
    for (int o = 1; o < 64; o <<= 1) v = fmaxf(v, __shfl_xor(v, o));
    return v;
}
#define LDS_WAIT() asm volatile("s_waitcnt lgkmcnt(0)" ::: "memory")
#define MFMA16(a, b, c) __builtin_amdgcn_mfma_f32_16x16x32_bf16((a), (b), (c), 0, 0, 0)

__device__ __forceinline__ f32x4 mod4(const float* b_ada, const unsigned char* ws, int b, int j) {
    const float* mp = (const float*)(ws + WS_MODP);
    f32x4 v = *(const f32x4*)(b_ada + j);
#pragma unroll
    for (int ks = 0; ks < 4; ++ks) v += *(const f32x4*)(mp + ((size_t)ks * NB + b) * 3072 + j);
    return v;
}

__device__ __forceinline__ void p0_transpose_item(const float* W, int K, int ldw, int nblk, bf16_t* WT, LAS float* scr, int item, int lane) {
    const int kb = item / nblk, nb = item % nblk, k0 = 64 * kb, n0 = 32 * nb;
#pragma unroll 8
    for (int i = 0; i < 32; ++i) { const int kk = 2 * i + (lane >> 5); scr[kk * 33 + (lane & 31)] = W[(size_t)(k0 + kk) * ldw + n0 + (lane & 31)]; }
    LDS_WAIT();
    const int c = lane & 7;
#pragma unroll
    for (int j = 0; j < 4; ++j) { const int n = (lane >> 3) + 8 * j; const LAS float* s = scr + (8 * c) * 33 + n;
        u32x4 o; o.x = pk2(s[0 * 33], s[1 * 33]); o.y = pk2(s[2 * 33], s[3 * 33]); o.z = pk2(s[4 * 33], s[5 * 33]); o.w = pk2(s[6 * 33], s[7 * 33]);
        *(u32x4*)(WT + (size_t)(n0 + n) * K + k0 + 8 * c) = o; }
    LDS_WAIT();
}
__device__ __forceinline__ void p0_adaln_item(const Ctx& C, int item) {
    const int cgp = item >> 2, ks = item & 3, lane = C.lane, kq = lane >> 3, j4 = lane & 7, j0 = 32 * cgp + 4 * j4;
    f32x4 acc[NB];
#pragma unroll
    for (int b = 0; b < NB; ++b) acc[b] = (f32x4){0.f, 0.f, 0.f, 0.f};
#pragma unroll 8
    for (int i = 0; i < 32; ++i) {
        const int k = 256 * ks + kq + 8 * i;
        const f32x4 w = *(const f32x4*)(C.w_ada + (size_t)k * 3072 + j0);
#pragma unroll
        for (int b = 0; b < NB; ++b) { const float s = fsilu(C.c[b * DM + k]); acc[b] += w * s; }
    }
#pragma unroll
    for (int b = 0; b < NB; ++b)
#pragma unroll
        for (int e = 0; e < 4; ++e) { float v = acc[b][e]; v += __shfl_xor(v, 8); v += __shfl_xor(v, 16); v += __shfl_xor(v, 32); acc[b][e] = v; }
    if (kq == 0) {
        float* mp = (float*)(C.ws + WS_MODP);
#pragma unroll
        for (int b = 0; b < NB; ++b) *(f32x4*)(mp + ((size_t)ks * NB + b) * 3072 + j0) = acc[b];
    }
}
__device__ __forceinline__ void p0_phase(const Ctx& C, LAS unsigned char* lds) {
    LAS float* scr = (LAS float*)(lds + C.wave * 8704);
    const int gw = blockIdx.x * NWAVES + C.wave, NGW = gridDim.x * NWAVES;
    constexpr int I_ADA = 96 * 4, I_IN = 16 * (NPROJ / 32), I_OUT = 16 * 32, I_POOL = 4 * 8, I_WG = 32;
    bf16_t* win = (bf16_t*)(C.ws + WS_WIN); bf16_t* wout = (bf16_t*)(C.ws + WS_WOUT); bf16_t* wpool = (bf16_t*)(C.ws + WS_WPOOL);
    for (int it = gw; it < I_ADA + I_IN + I_OUT + I_POOL + I_WG; it += NGW) {
        int r = it;
        if (r < I_ADA) { p0_adaln_item(C, r); continue; } r -= I_ADA;
        if (r < I_IN) { p0_transpose_item(C.w_in, DM, LDW, NPROJ / 32, win, scr, r, C.lane); continue; } r -= I_IN;
        if (r < I_OUT) { p0_transpose_item(C.w_out, DM, DM, 32, wout, scr, r, C.lane); continue; } r -= I_OUT;
        if (r < I_POOL) { const int g = r >> 3; p0_transpose_item(C.w_pool + (size_t)g * 16384, 128, 128, 4, wpool + (size_t)g * 16384, scr, r & 7, C.lane); continue; } r -= I_POOL;
        { const int half = r & 1, ji = r >> 1;
          ((f32x4*)(C.ws + WS_WGT))[r * 64 + C.lane] = *(const f32x4*)(C.w_in + (size_t)(4 * C.lane + 256 * (ji >> 2) + (ji & 3)) * LDW + C_G + 4 * half); }
    }
}

__device__ __forceinline__ void p1_phase(const Ctx& C) {
    const int gw = blockIdx.x * NWAVES + C.wave, NGW = gridDim.x * NWAVES, lane = C.lane;
    bf16_t* H = (bf16_t*)(C.ws + WS_H); float* G = (float*)(C.ws + WS_GATES);
    f32x4 wg[4][4][2];
    { const f32x4* T = (const f32x4*)(C.ws + WS_WGT) + lane;
#pragma unroll
      for (int j = 0; j < 4; ++j)
#pragma unroll
        for (int i = 0; i < 4; ++i) { wg[j][i][0] = T[((j * 4 + i) * 2) * 64]; wg[j][i][1] = T[((j * 4 + i) * 2 + 1) * 64]; } }
    const int gidx = ((lane >> 5) & 1) * 4 + ((lane >> 4) & 1) * 2 + ((lane >> 3) & 1);
    const float bgate = C.b_gates[gidx];
    constexpr int RPW = 16;
    for (int item = gw; item < MROWS / RPW; item += NGW) {
        const int m0 = item * RPW, b = m0 / SEQ;
        f32x4 ga[4], gb[4];
#pragma unroll
        for (int j = 0; j < 4; ++j) { const int k = 4 * lane + 256 * j; const f32x4 sh = mod4(C.b_ada, C.ws, b, k), sc = mod4(C.b_ada, C.ws, b, 1024 + k), ng = *(const f32x4*)(C.norm_g + k);
            ga[j] = ng * (sc + 1.0f); gb[j] = sh; }
        f32x4 v[4];
        { const f32x4* xr = (const f32x4*)(C.x + (size_t)m0 * DM) + lane;
#pragma unroll
          for (int j = 0; j < 4; ++j) v[j] = xr[64 * j]; }
        for (int r = 0; r < RPW; ++r) {
            const int m = m0 + r;
            f32x4 vn[4];
            { const f32x4* xn = (const f32x4*)(C.x + (size_t)(m + (r + 1 < RPW ? 1 : 0)) * DM) + lane;
#pragma unroll
              for (int j = 0; j < 4; ++j) vn[j] = xn[64 * j]; }
            float ss = 0.f;
#pragma unroll
            for (int j = 0; j < 4; ++j) ss += (v[j].x * v[j].x + v[j].y * v[j].y) + (v[j].z * v[j].z + v[j].w * v[j].w);
            const float rstd = 1.0f / sqrtf(wave_sum(ss) * (1.0f / DM) + EPS);
            f32x4 g0 = (f32x4){0.f, 0.f, 0.f, 0.f}, g1 = g0;
            u32x2* hp = (u32x2*)(H + (size_t)m * DM) + lane;
#pragma unroll
            for (int j = 0; j < 4; ++j) {
                const f32x4 hv = v[j] * rstd * ga[j] + gb[j];
                u32x2 o; o.x = pk2(hv.x, hv.y); o.y = pk2(hv.z, hv.w); hp[64 * j] = o;
#pragma unroll
                for (int i = 0; i < 4; ++i) { g0 += wg[j][i][0] * hv[i]; g1 += wg[j][i][1] * hv[i]; }
            }
            float t[4], u2[2], w;
            { const bool up = (lane & 32) != 0;
#pragma unroll
              for (int e = 0; e < 4; ++e) { const float send = up ? g0[e] : g1[e], keep = up ? g1[e] : g0[e]; t[e] = keep + __shfl_xor(send, 32); } }
            { const bool up = (lane & 16) != 0;
#pragma unroll
              for (int e = 0; e < 2; ++e) { const float send = up ? t[e] : t[e + 2], keep = up ? t[e + 2] : t[e]; u2[e] = keep + __shfl_xor(send, 16); } }
            { const bool up = (lane & 8) != 0; const float send = up ? u2[0] : u2[1], keep = up ? u2[1] : u2[0]; w = keep + __shfl_xor(send, 8); }
            w += __shfl_xor(w, 4); w += __shfl_xor(w, 2); w += __shfl_xor(w, 1);
            if ((lane & 7) == 0) {
                w += bgate;
                if (gidx >= 4) w = fminf(w, 0.f) - log1pf(__expf(-fabsf(w)));
                G[(size_t)m * 8 + gidx] = w;
            }
#pragma unroll
            for (int j = 0; j < 4; ++j) v[j] = vn[j];
        }
    }
}

__device__ __forceinline__ void conv_qk(const Ctx& C, const bf16_t* proj, int colbase  , int wcol  , size_t row0, int chunk, int dp, int seg, float scale, float (&o)[16][2]) {
    float w[4][2], bias[2];
#pragma unroll
    for (int j = 0; j < 4; ++j) { const f32x2 t = *(const f32x2*)(C.conv_w + (size_t)j * 1024 + wcol + 2 * dp); w[j][0] = t.x; w[j][1] = t.y; }
    { const f32x2 t = *(const f32x2*)(C.conv_b + wcol + 2 * dp); bias[0] = t.x; bias[1] = t.y; }
    float xv[19][2];
#pragma unroll
    for (int i = 0; i < 19; ++i) {
        const int s = seg * 16 - 3 + i;
        unsigned u = 0u;
        if (chunk > 0 || s >= 0) u = *(const unsigned*)(proj + (row0 + s) * (size_t)NPROJ + colbase + 2 * dp);
        xv[i][0] = bflo(u); xv[i][1] = bfhi(u);
    }
#pragma unroll
    for (int i = 0; i < 16; ++i)
#pragma unroll
        for (int e = 0; e < 2; ++e) {
            const float y = bias[e] + w[0][e] * xv[i][e] + w[1][e] * xv[i + 1][e] + w[2][e] * xv[i + 2][e] + w[3][e] * xv[i + 3][e];
            o[i][e] = fsilu(y) * scale;
        }
}
__device__ __forceinline__ void mlstm_a_unit(const Ctx& C, LAS unsigned char* lds, int unit) {
    const int tid = C.tid, lane = C.lane, wave = C.wave;
    const int bh = unit >> 6, chunk = unit & 63, b = bh >> 2, h = bh & 3;
    const size_t row0 = (size_t)b * SEQ + (size_t)chunk * CH;
    LAS bf16_t* Kt = (LAS bf16_t*)lds;
    LAS bf16_t* Vt = (LAS bf16_t*)(lds + 128 * LP * 2);
    LAS float* garr = (LAS float*)(lds + (128 + 144) * LP * 2);
    const bf16_t* proj = (const bf16_t*)(C.ws + WS_PROJ);
    const float* G = (const float*)(C.ws + WS_GATES);
    if (wave == 0) {
        const float ig0 = G[(row0 + 2 * lane) * 8 + h], ig1 = G[(row0 + 2 * lane + 1) * 8 + h];
        const float lf0 = G[(row0 + 2 * lane) * 8 + 4 + h], lf1 = G[(row0 + 2 * lane + 1) * 8 + 4 + h];
        float incl = lf0 + lf1;
#pragma unroll
        for (int o = 1; o < 64; o <<= 1) { const float t = __shfl_up(incl, o); if (lane >= o) incl += t; }
        const float b1 = incl, b0 = incl - lf1, bL = __shfl(incl, 63);
        const float wl0 = bL - b0 + ig0, wl1 = bL - b1 + ig1;
        const float mloc = wave_max(fmaxf(wl0, wl1));
        garr[2 * lane] = __expf(wl0 - mloc); garr[2 * lane + 1] = __expf(wl1 - mloc);
        if (lane == 0) { ((float*)(C.ws + WS_MLOC))[unit] = mloc; ((float*)(C.ws + WS_BL))[unit] = bL; }
    }
    const int dp = tid & 63, seg = tid >> 6;
    {
        float o[16][2];
        conv_qk(C, proj, C_K + h * 128, 512 + h * 128, row0, chunk, dp, seg, 0.08838834764831845f, o);
        bf16_t* kc = (bf16_t*)(C.ws + WS_KC);
#pragma unroll
        for (int i = 0; i < 16; ++i) *(unsigned*)(kc + (row0 + seg * 16 + i) * 512 + h * 128 + 2 * dp) = pk2(o[i][0], o[i][1]);
#pragma unroll
        for (int e = 0; e < 2; ++e) {
            u32x4 lo, hi;
            lo.x = pk2(o[0][e], o[1][e]); lo.y = pk2(o[2][e], o[3][e]); lo.z = pk2(o[4][e], o[5][e]); lo.w = pk2(o[6][e], o[7][e]);
            hi.x = pk2(o[8][e], o[9][e]); hi.y = pk2(o[10][e], o[11][e]); hi.z = pk2(o[12][e], o[13][e]); hi.w = pk2(o[14][e], o[15][e]);
            LAS u32x4* p = (LAS u32x4*)(Kt + (2 * dp + e) * LP + seg * 16); p[0] = lo; p[1] = hi;
        }
    }
    {
        float o[16][2];
        conv_qk(C, proj, C_Q + h * 128, h * 128, row0, chunk, dp, seg, 1.0f, o);
        bf16_t* qc = (bf16_t*)(C.ws + WS_QC);
#pragma unroll
        for (int i = 0; i < 16; ++i) *(unsigned*)(qc + (row0 + seg * 16 + i) * 512 + h * 128 + 2 * dp) = pk2(o[i][0], o[i][1]);
    }
    unsigned vraw[16];
#pragma unroll
    for (int i = 0; i < 16; ++i) vraw[i] = *(const unsigned*)(proj + (row0 + seg * 16 + i) * (size_t)NPROJ + C_V + h * 128 + 2 * dp);
    __syncthreads();
    {
        float wv[16];
#pragma unroll
        for (int i = 0; i < 16; i += 4) { const f32x4 t = *(const LAS f32x4*)(garr + seg * 16 + i); wv[i] = t.x; wv[i + 1] = t.y; wv[i + 2] = t.z; wv[i + 3] = t.w; }
#pragma unroll
        for (int e = 0; e < 2; ++e) {
            float f[16];
#pragma unroll
            for (int i = 0; i < 16; ++i) f[i] = (e ? bfhi(vraw[i]) : bflo(vraw[i])) * wv[i];
            u32x4 lo, hi;
            lo.x = pk2(f[0], f[1]); lo.y = pk2(f[2], f[3]); lo.z = pk2(f[4], f[5]); lo.w = pk2(f[6], f[7]);
            hi.x = pk2(f[8], f[9]); hi.y = pk2(f[10], f[11]); hi.z = pk2(f[12], f[13]); hi.w = pk2(f[14], f[15]);
            LAS u32x4* p = (LAS u32x4*)(Vt + (2 * dp + e) * LP + seg * 16); p[0] = lo; p[1] = hi;
        }
        const int r = 128 + (tid >> 5), s4 = (tid & 31) * 4;
        u32x2 z; z.x = 0u; z.y = 0u;
        if (r == 128) { const f32x4 t = *(const LAS f32x4*)(garr + s4); z.x = pk2(t.x, t.y); z.y = pk2(t.z, t.w); }
        *(LAS u32x2*)(Vt + r * LP + s4) = z;
    }
    __syncthreads();
    f32x4 acc[8], accn = (f32x4){0.f, 0.f, 0.f, 0.f};
#pragma unroll
    for (int nt = 0; nt < 8; ++nt) acc[nt] = (f32x4){0.f, 0.f, 0.f, 0.f};
    const int fr = lane & 15, fq = lane >> 4;
#pragma unroll
    for (int ks = 0; ks < 4; ++ks) {
        const bf16x8 bv = *(const LAS bf16x8*)(Vt + (16 * wave + fr) * LP + 32 * ks + 8 * fq);
        const bf16x8 bn = *(const LAS bf16x8*)(Vt + (128 + fr) * LP + 32 * ks + 8 * fq);
        const bf16x8 aw = *(const LAS bf16x8*)(Kt + (16 * wave + fr) * LP + 32 * ks + 8 * fq);
        accn = MFMA16(aw, bn, accn);
#pragma unroll
        for (int nt = 0; nt < 8; ++nt) { const bf16x8 a = *(const LAS bf16x8*)(Kt + (16 * nt + fr) * LP + 32 * ks + 8 * fq); acc[nt] = MFMA16(a, bv, acc[nt]); }
    }
    float* dc = (float*)((unsigned char*)C.out + OUT_DC) + (size_t)unit * 16384 + (size_t)(16 * wave + fr) * 128 + 4 * fq;
#pragma unroll
    for (int nt = 0; nt < 8; ++nt) *(f32x4*)(dc + 16 * nt) = acc[nt];
    if (fr == 0) *(f32x4*)((float*)(C.ws + WS_DN) + (size_t)unit * 128 + 16 * wave + 4 * fq) = accn;
    __syncthreads();
}

template <int W>
__device__ __forceinline__ void pool_compute(const bf16_t* proj, size_t row0, int chunk, int g, int cp, int seg, LAS bf16_t* Ps) {
    float v[31][2];
#pragma unroll
    for (int i = 0; i < 31; ++i) {
        v[i][0] = 0.f; v[i][1] = 0.f;
        if (i >= 16 - W) {
            const int s = seg * 16 - 15 + i;
            unsigned u = 0u;
            if (chunk > 0 || s >= 0) u = *(const unsigned*)(proj + (row0 + s) * (size_t)NPROJ + C_U + g * 128 + 2 * cp);
            v[i][0] = bflo(u); v[i][1] = bfhi(u);
        }
    }
    float s0 = 0.f, s1 = 0.f;
#pragma unroll
    for (int j = 16 - W; j < 16; ++j) { s0 += v[j][0]; s1 += v[j][1]; }
#pragma unroll
    for (int i = 0; i < 16; ++i) {
        if (i > 0) { s0 += v[15 + i][0] - v[15 + i - W][0]; s1 += v[15 + i][1] - v[15 + i - W][1]; }
        const int pos = chunk * CH + seg * 16 + i;
        const float inv = 1.0f / (float)(pos + 1 < W ? pos + 1 : W);
        *(LAS unsigned*)(Ps + (seg * 16 + i) * LP + 2 * cp) = pk2(s0 * inv - v[15 + i][0], s1 * inv - v[15 + i][1]);
    }
}
__device__ __forceinline__ void pool_unit(const Ctx& C, LAS unsigned char* lds, int pu) {
    const int tid = C.tid, lane = C.lane, wave = C.wave;
    const int g = pu & 3, chunk = (pu >> 2) & 63, b = pu >> 8;
    const size_t row0 = (size_t)b * SEQ + (size_t)chunk * CH;
    LAS bf16_t* Ps = (LAS bf16_t*)lds;
    LAS bf16_t* Ws = (LAS bf16_t*)(lds + 128 * LP * 2);
    const bf16_t* proj = (const bf16_t*)(C.ws + WS_PROJ);
    const bf16_t* wsrc = (const bf16_t*)(C.ws + WS_WPOOL) + (size_t)g * 16384;
#pragma unroll
    for (int i = 0; i < 4; ++i) { const int q = tid + 512 * i, r = q >> 4, c16 = q & 15; *(LAS u32x4*)(Ws + r * LP + c16 * 8) = *(const u32x4*)(wsrc + r * 128 + c16 * 8); }
    const int cp = tid & 63, seg = tid >> 6;
    if (g == 0) pool_compute<2>(proj, row0, chunk, g, cp, seg, Ps);
    else if (g == 1) pool_compute<4>(proj, row0, chunk, g, cp, seg, Ps);
    else if (g == 2) pool_compute<8>(proj, row0, chunk, g, cp, seg, Ps);
    else pool_compute<16>(proj, row0, chunk, g, cp, seg, Ps);
    __syncthreads();
    f32x4 acc[8];
#pragma unroll
    for (int nt = 0; nt < 8; ++nt) acc[nt] = (f32x4){0.f, 0.f, 0.f, 0.f};
    const int fr = lane & 15, fq = lane >> 4;
#pragma unroll
    for (int ks = 0; ks < 4; ++ks) {
        const bf16x8 bp = *(const LAS bf16x8*)(Ps + (16 * wave + fr) * LP + 32 * ks + 8 * fq);
#pragma unroll
        for (int nt = 0; nt < 8; ++nt) { const bf16x8 a = *(const LAS bf16x8*)(Ws + (16 * nt + fr) * LP + 32 * ks + 8 * fq); acc[nt] = MFMA16(a, bp, acc[nt]); }
    }
    const size_t row = row0 + 16 * wave + fr;
    bf16_t* mix = (bf16_t*)(C.ws + WS_H);
#pragma unroll
    for (int nt = 0; nt < 8; ++nt) {
        const int col = g * 128 + 16 * nt + 4 * fq;
        const f32x4 ls = *(const f32x4*)(C.ls_pool + col);
        const u32x2 z = *(const u32x2*)(proj + row * NPROJ + C_ZP + col);
        const f32x4 y = acc[nt] * ls;
        u32x2 o; o.x = pk2(y.x * fsilu(bflo(z.x)), y.y * fsilu(bfhi(z.x))); o.y = pk2(y.z * fsilu(bflo(z.y)), y.w * fsilu(bfhi(z.y)));
        *(u32x2*)(mix + row * DM + col) = o;
    }
    __syncthreads();
}

__device__ __forceinline__ void p4_phase(const Ctx& C) {
    const float* dc = (const float*)((const unsigned char*)C.out + OUT_DC);
    bf16_t* cprev = (bf16_t*)((unsigned char*)C.out + OUT_CPREV);
    const float* mloc = (const float*)(C.ws + WS_MLOC); const float* bl = (const float*)(C.ws + WS_BL);
    const float* dn = (const float*)(C.ws + WS_DN); float* nprev = (float*)(C.ws + WS_NPREV); float* mprev = (float*)(C.ws + WS_MPREV);
    const int gt = blockIdx.x * NTHREADS + C.tid, NT = gridDim.x * NTHREADS;
    constexpr int BT = 16;
    constexpr int NC4 = 16 * 4096, NN2 = 16 * 64;
    for (int e = gt; e < NC4 + NN2; e += NT) {
        if (e < NC4) {
            const int bh = e >> 12, idx = (e & 4095) * 4;
            const float* src = dc + (size_t)bh * NCH * 16384 + idx;
            f32x4 c = (f32x4){0.f, 0.f, 0.f, 0.f}; float m = 0.f;
            for (int cb = 0; cb < NCH; cb += BT) {
                f32x4 d[BT]; float ml[BT], bb[BT];
#pragma unroll
                for (int i = 0; i < BT; ++i) { const int unit = bh * NCH + cb + i; d[i] = *(const f32x4*)(src + (size_t)(cb + i) * 16384); ml[i] = mloc[unit]; bb[i] = bl[unit]; }
#pragma unroll
                for (int i = 0; i < BT; ++i) {
                    const int unit = bh * NCH + cb + i;
                    u32x2 o; o.x = pk2(c.x, c.y); o.y = pk2(c.z, c.w);
                    *(u32x2*)(cprev + (size_t)unit * 16384 + idx) = o;
                    const float bm = bb[i] + m, mn = fmaxf(bm, ml[i]), f1 = __expf(bm - mn), f2 = __expf(ml[i] - mn);
                    c = c * f1 + d[i] * f2; m = mn;
                }
            }
        } else {
            const int e2 = e - NC4, bh = e2 >> 6, idx = (e2 & 63) * 2;
            const float* src = dn + (size_t)bh * NCH * 128 + idx;
            float c0 = 0.f, c1 = 0.f, m = 0.f;
            for (int cb = 0; cb < NCH; cb += BT) {
                f32x2 d[BT]; float ml[BT], bb[BT];
#pragma unroll
                for (int i = 0; i < BT; ++i) { const int unit = bh * NCH + cb + i; d[i] = *(const f32x2*)(src + (size_t)(cb + i) * 128); ml[i] = mloc[unit]; bb[i] = bl[unit]; }
#pragma unroll
                for (int i = 0; i < BT; ++i) {
                    const int unit = bh * NCH + cb + i;
                    *(f32x2*)(nprev + (size_t)unit * 128 + idx) = (f32x2){c0, c1}; if (idx == 0) mprev[unit] = m;
                    const float bm = bb[i] + m, mn = fmaxf(bm, ml[i]), f1 = __expf(bm - mn), f2 = __expf(ml[i] - mn);
                    c0 = f1 * c0 + f2 * d[i].x; c1 = f1 * c1 + f2 * d[i].y; m = mn;
                }
            }
        }
    }
}

__device__ __forceinline__ void mlstm_c_unit(const Ctx& C, LAS unsigned char* lds, int unit) {
    const int tid = C.tid, lane = C.lane, wave = C.wave;
    const int bh = unit >> 6, chunk = unit & 63, b = bh >> 2, h = bh & 3;
    const size_t row0 = (size_t)b * SEQ + (size_t)chunk * CH;
    LAS bf16_t* Ks = (LAS bf16_t*)lds;
    LAS bf16_t* Vt = (LAS bf16_t*)(lds + 128 * LP * 2);
    LAS bf16_t* Cs = (LAS bf16_t*)(lds + (128 + 144) * LP * 2);
    LAS bf16_t* Ss = (LAS bf16_t*)(lds + (128 + 288) * LP * 2);
    LAS float* arr = (LAS float*)(lds + (256 + 288) * LP * 2);
    const bf16_t* proj = (const bf16_t*)(C.ws + WS_PROJ);
    const float* G = (const float*)(C.ws + WS_GATES);
    const float mprev = ((const float*)(C.ws + WS_MPREV))[unit];
    if (wave == 0) {
        const float ig0 = G[(row0 + 2 * lane) * 8 + h], ig1 = G[(row0 + 2 * lane + 1) * 8 + h];
        const float lf0 = G[(row0 + 2 * lane) * 8 + 4 + h], lf1 = G[(row0 + 2 * lane + 1) * 8 + 4 + h];
        float incl = lf0 + lf1;
#pragma unroll
        for (int o = 1; o < 64; o <<= 1) { const float t = __shfl_up(incl, o); if (lane >= o) incl += t; }
        const float b1 = incl, b0 = incl - lf1, a0 = ig0 - b0, a1 = ig1 - b1;
        float mx = fmaxf(a0, a1);
#pragma unroll
        for (int o = 1; o < 64; o <<= 1) { const float t = __shfl_up(mx, o); if (lane >= o) mx = fmaxf(mx, t); }
        float ex = __shfl_up(mx, 1); if (lane == 0) ex = -INFINITY;
        const float M0 = fmaxf(mprev, fmaxf(ex, a0)), M1 = fmaxf(mprev, mx);
        arr[2 * lane] = a0; arr[2 * lane + 1] = a1; arr[128 + 2 * lane] = M0; arr[128 + 2 * lane + 1] = M1; arr[256 + 2 * lane] = b0; arr[256 + 2 * lane + 1] = b1;
    }
    {
        const bf16_t* kc = (const bf16_t*)(C.ws + WS_KC) + row0 * 512 + h * 128;
        const bf16_t* cp = (const bf16_t*)((const unsigned char*)C.out + OUT_CPREV) + (size_t)unit * 16384;
#pragma unroll
        for (int i = 0; i < 4; ++i) { const int q = tid + 512 * i, r = q >> 4, c16 = q & 15;
            *(LAS u32x4*)(Ks + r * LP + c16 * 8) = *(const u32x4*)(kc + (size_t)r * 512 + c16 * 8);
            *(LAS u32x4*)(Cs + r * LP + c16 * 8) = *(const u32x4*)(cp + r * 128 + c16 * 8); }
        const int vp = tid & 63, seg = tid >> 6;
        unsigned vraw[16];
#pragma unroll
        for (int i = 0; i < 16; ++i) vraw[i] = *(const unsigned*)(proj + (row0 + seg * 16 + i) * (size_t)NPROJ + C_V + h * 128 + 2 * vp);
#pragma unroll
        for (int e = 0; e < 2; ++e) {
            u32x4 lo, hi;
            if (e == 0) {
                lo.x = (vraw[0] & 0xffffu) | (vraw[1] << 16); lo.y = (vraw[2] & 0xffffu) | (vraw[3] << 16); lo.z = (vraw[4] & 0xffffu) | (vraw[5] << 16); lo.w = (vraw[6] & 0xffffu) | (vraw[7] << 16);
                hi.x = (vraw[8] & 0xffffu) | (vraw[9] << 16); hi.y = (vraw[10] & 0xffffu) | (vraw[11] << 16); hi.z = (vraw[12] & 0xffffu) | (vraw[13] << 16); hi.w = (vraw[14] & 0xffffu) | (vraw[15] << 16);
            } else {
                lo.x = (vraw[0] >> 16) | (vraw[1] & 0xffff0000u); lo.y = (vraw[2] >> 16) | (vraw[3] & 0xffff0000u); lo.z = (vraw[4] >> 16) | (vraw[5] & 0xffff0000u); lo.w = (vraw[6] >> 16) | (vraw[7] & 0xffff0000u);
                hi.x = (vraw[8] >> 16) | (vraw[9] & 0xffff0000u); hi.y = (vraw[10] >> 16) | (vraw[11] & 0xffff0000u); hi.z = (vraw[12] >> 16) | (vraw[13] & 0xffff0000u); hi.w = (vraw[14] >> 16) | (vraw[15] & 0xffff0000u);
            }
            LAS u32x4* p = (LAS u32x4*)(Vt + (2 * vp + e) * LP + seg * 16); p[0] = lo; p[1] = hi;
        }
        const int r = 128 + (tid >> 5), s4 = (tid & 31) * 4;
        u32x2 zv, zc; zv.x = 0u; zv.y = 0u; zc = zv;
        if (r == 128) { zv.x = 0x3f803f80u; zv.y = 0x3f803f80u;
            const f32x4 nn = *(const f32x4*)((const float*)(C.ws + WS_NPREV) + (size_t)unit * 128 + s4); zc.x = pk2(nn.x, nn.y); zc.y = pk2(nn.z, nn.w); }
        *(LAS u32x2*)(Vt + r * LP + s4) = zv; *(LAS u32x2*)(Cs + r * LP + s4) = zc;
    }
    const int fr = lane & 15, fq = lane >> 4;
    const size_t trow = row0 + 16 * wave + fr;
    bf16x8 qf[4];
    { const bf16_t* qp = (const bf16_t*)(C.ws + WS_QC) + trow * 512 + h * 128 + 8 * fq;
#pragma unroll
      for (int ks = 0; ks < 4; ++ks) qf[ks] = *(const bf16x8*)(qp + 32 * ks); }
    __syncthreads();
    const float Mt = arr[128 + 16 * wave + fr], btv = arr[256 + 16 * wave + fr];
#pragma unroll
    for (int nt = 0; nt < 8; ++nt) {
        if (nt <= (wave | 1)) {
            u32x2 o; o.x = 0u; o.y = 0u;
            if (nt <= wave) {
                f32x4 s = (f32x4){0.f, 0.f, 0.f, 0.f};
#pragma unroll
                for (int ks = 0; ks < 4; ++ks) { const bf16x8 a = *(const LAS bf16x8*)(Ks + (16 * nt + fr) * LP + 32 * ks + 8 * fq); s = MFMA16(a, qf[ks], s); }
                const f32x4 a4 = *(const LAS f32x4*)(arr + 16 * nt + 4 * fq);
                float v[4];
#pragma unroll
                for (int r = 0; r < 4; ++r) { const int sidx = 16 * nt + 4 * fq + r; v[r] = (sidx <= 16 * wave + fr) ? s[r] * __expf(a4[r] - Mt) : 0.f; }
                o.x = pk2(v[0], v[1]); o.y = pk2(v[2], v[3]);
            }
            *(LAS u32x2*)(Ss + (16 * wave + fr) * LP + 16 * nt + 4 * fq) = o;
        }
    }
    LDS_WAIT();
    f32x4 acc1[9], acc2[9];
#pragma unroll
    for (int nt = 0; nt < 9; ++nt) { acc1[nt] = (f32x4){0.f, 0.f, 0.f, 0.f}; acc2[nt] = (f32x4){0.f, 0.f, 0.f, 0.f}; }
#pragma unroll
    for (int ks = 0; ks < 4; ++ks) {
        if (ks <= (wave >> 1)) {
            const bf16x8 sf = *(const LAS bf16x8*)(Ss + (16 * wave + fr) * LP + 32 * ks + 8 * fq);
#pragma unroll
            for (int nt = 0; nt < 9; ++nt) { const bf16x8 a = *(const LAS bf16x8*)(Vt + (16 * nt + fr) * LP + 32 * ks + 8 * fq); acc1[nt] = MFMA16(a, sf, acc1[nt]); }
        }
    }
#pragma unroll
    for (int ks = 0; ks < 4; ++ks) {
#pragma unroll
        for (int nt = 0; nt < 9; ++nt) { const bf16x8 a = *(const LAS bf16x8*)(Cs + (16 * nt + fr) * LP + 32 * ks + 8 * fq); acc2[nt] = MFMA16(a, qf[ks], acc2[nt]); }
    }
    const float inter = __expf(mprev - Mt), mt = btv + Mt;
    float den = acc1[8][0] + inter * acc2[8][0];
    den = __shfl(den, fr);
    const float inv = 1.0f / fmaxf(fabsf(den), __expf(-mt));
    float ss = 0.f;
#pragma unroll
    for (int nt = 0; nt < 8; ++nt) { acc1[nt] = (acc1[nt] + acc2[nt] * inter) * inv; ss += (acc1[nt].x * acc1[nt].x + acc1[nt].y * acc1[nt].y) + (acc1[nt].z * acc1[nt].z + acc1[nt].w * acc1[nt].w); }
    ss += __shfl_xor(ss, 16); ss += __shfl_xor(ss, 32);
    const float rstd = 1.0f / sqrtf(ss * (1.0f / DH) + EPS);
    bf16_t* mix = (bf16_t*)(C.ws + WS_H);
#pragma unroll
    for (int nt = 0; nt < 8; ++nt) {
        const int col = h * 128 + 16 * nt + 4 * fq;
        const f32x4 g4 = *(const f32x4*)(C.mh_norm_g + col);
        const u32x2 o4 = *(const u32x2*)(proj + trow * NPROJ + C_O + col);
        const u32x2 z4 = *(const u32x2*)(proj + trow * NPROJ + C_ZM + col);
        const f32x4 y = acc1[nt] * rstd * g4;
        u32x2 o;
        o.x = pk2(y.x * fsigm(bflo(o4.x)) * fsilu(bflo(z4.x)), y.y * fsigm(bfhi(o4.x)) * fsilu(bfhi(z4.x)));
        o.y = pk2(y.z * fsigm(bflo(o4.y)) * fsilu(bflo(z4.y)), y.w * fsigm(bfhi(o4.y)) * fsilu(bfhi(z4.y)));
        *(u32x2*)(mix + trow * DM + 512 + col) = o;
    }
    __syncthreads();
}

struct EpiResGate {
    static constexpr bool PERM = false, AFTER_DRAIN = false;
    const float* x; float* out; const float* b_ada; const unsigned char* ws;
    __device__ __forceinline__ void operator()(const f32x4 (&acc)[2][2][4][2], const pg8::Unit& u, int wr, int wc, int fr, int fq) const {
        const int row0 = u.pm * 256 + wr * 64 + fr, col0 = u.pn * 256 + wc * 32 + 4 * fq, b = (u.pm * 256) / SEQ;
        f32x4 gv[2][2];
#pragma unroll
        for (int bj = 0; bj < 2; ++bj)
#pragma unroll
            for (int n = 0; n < 2; ++n) gv[bj][n] = mod4(b_ada, ws, b, 2048 + col0 + bj * 128 + n * 16);
#pragma unroll
        for (int ai = 0; ai < 2; ++ai)
#pragma unroll
            for (int m = 0; m < 4; ++m) {
                const size_t off = (size_t)(row0 + ai * 128 + m * 16) * DM + col0;
#pragma unroll
                for (int bj = 0; bj < 2; ++bj)
#pragma unroll
                    for (int n = 0; n < 2; ++n) { const f32x4 xv = *(const f32x4*)(x + off + bj * 128 + n * 16); *(f32x4*)(out + off + bj * 128 + n * 16) = xv + gv[bj][n] * acc[ai][bj][m][n]; }
            }
    }
};

__device__ __forceinline__ void p7_phase(const Ctx& C) {
    const int gw = blockIdx.x * NWAVES + C.wave, NGW = gridDim.x * NWAVES, lane = C.lane;
    f32x4 fg[4];
#pragma unroll
    for (int j = 0; j < 4; ++j) fg[j] = *(const f32x4*)(C.final_g + 4 * lane + 256 * j);
    for (int m = gw; m < MROWS; m += NGW) {
        f32x4* xr = (f32x4*)(C.out + (size_t)m * DM) + lane;
        f32x4 v[4]; float ss = 0.f;
#pragma unroll
        for (int j = 0; j < 4; ++j) { v[j] = xr[64 * j]; ss += (v[j].x * v[j].x + v[j].y * v[j].y) + (v[j].z * v[j].z + v[j].w * v[j].w); }
        const float rstd = 1.0f / sqrtf(wave_sum(ss) * (1.0f / DM) + EPS);
#pragma unroll
        for (int j = 0; j < 4; ++j) xr[64 * j] = v[j] * rstd * fg[j];
    }
}

__global__ void __launch_bounds__(NTHREADS, 2) fwd_megakernel(Args args) {
    extern __shared__ __attribute__((aligned(16))) unsigned char lds_raw[];
    LAS unsigned char* lds = (LAS unsigned char*)lds_raw;
    cg::grid_group grid = cg::this_grid();
    Ctx C;
    C.x = args.in[0]; C.c = args.in[1]; C.norm_g = args.in[2]; C.w_ada = args.in[3]; C.b_ada = args.in[4]; C.w_in = args.in[5]; C.b_gates = args.in[6];
    C.conv_w = args.in[7]; C.conv_b = args.in[8]; C.w_pool = args.in[9]; C.ls_pool = args.in[10]; C.mh_norm_g = args.in[11]; C.w_out = args.in[12]; C.final_g = args.in[13];
    C.out = args.out; C.ws = args.ws;
    C.tid = threadIdx.x; C.lane = C.tid & 63; C.wave = __builtin_amdgcn_readfirstlane(C.tid >> 6);
    const int lo = args.ph_lo, hi = args.ph_hi;
#define IN(k) (lo <= (k) && (k) < hi)
#define SEAM(k) do { if (IN(k) && IN((k) + 1)) grid.sync(); } while (0)
#define RUN(k, body) do { if (IN(k)) { for (int rep_ = 0; rep_ < REPS[k]; ++rep_) { if (rep_) grid.sync(); body; } } } while (0)
    RUN(0, p0_phase(C, lds));
    SEAM(0);
    RUN(1, p1_phase(C));
    SEAM(1);
    RUN(2, ({
        pg8::Gemm g{(const bf16_t*)(C.ws + WS_H), (const bf16_t*)(C.ws + WS_WIN), MROWS, NPROJ, DM};
        pg8::StaticOrder S; S.init(MROWS, NPROJ, (int)gridDim.x, (int)blockIdx.x);
        pg8::EpiBf16<0> E{(bf16_t*)(C.ws + WS_PROJ), NPROJ, nullptr, 0, 0};
        pg8::gemm_phase<pg8::EpiBf16<0>, pg8::StaticOrder>(lds, g, S, E, nullptr);
        __syncthreads();
    }));
    SEAM(2);
    RUN(3, ({ for (int u = blockIdx.x; u < 2 * NUNIT; u += gridDim.x) { if (u < NUNIT) mlstm_a_unit(C, lds, u); else pool_unit(C, lds, u - NUNIT); } }));
    SEAM(3);
    RUN(4, p4_phase(C));
    SEAM(4);
    RUN(5, ({ for (int u = blockIdx.x; u < NUNIT; u += gridDim.x) mlstm_c_unit(C, lds, u); }));
    SEAM(5);
    RUN(6, ({
        pg8::Gemm g{(const bf16_t*)(C.ws + WS_H), (const bf16_t*)(C.ws + WS_WOUT), MROWS, DM, DM};
        pg8::StaticOrder S; S.init(MROWS, DM, (int)gridDim.x, (int)blockIdx.x);
        EpiResGate E{C.x, C.out, C.b_ada, C.ws};
        pg8::gemm_phase<EpiResGate, pg8::StaticOrder>(lds, g, S, E, nullptr);
        __syncthreads();
    }));
    SEAM(6);
    RUN(7, p7_phase(C));
#undef RUN
#undef IN
#undef SEAM
}

#ifndef MK_N_LAUNCHES
#define MK_N_LAUNCHES 1
#endif
extern "C" void kernel_launch(void* const* d_in, const int* in_sizes, int n_in, void* d_out, int out_size, void* d_ws, size_t ws_size, hipStream_t stream) {
    static int grid = 0;
    if (grid == 0) {
        if (n_in != 14 || out_size != MROWS * DM || ws_size < WS_END) { fprintf(stderr, "kernel_launch: unexpected shapes (n_in %d out %d ws %zu need %zu)\n", n_in, out_size, ws_size, (size_t)WS_END); grid = -1; return; }
        int dev = 0, cus = 0, per_cu = 0;
        hipGetDevice(&dev);
        hipDeviceGetAttribute(&cus, hipDeviceAttributeMultiprocessorCount, dev);
        if (hipFuncSetAttribute((const void*)fwd_megakernel, hipFuncAttributeMaxDynamicSharedMemorySize, LDS_BYTES) != hipSuccess) { fprintf(stderr, "kernel_launch: hipFuncSetAttribute failed\n"); grid = -1; return; }
        if (hipOccupancyMaxActiveBlocksPerMultiprocessor(&per_cu, (const void*)fwd_megakernel, NTHREADS, LDS_BYTES) != hipSuccess || per_cu < 1) { fprintf(stderr, "kernel_launch: occupancy query says %d\n", per_cu); per_cu = 1; }
        (void)hipGetLastError();
        grid = cus * 1;
        if (grid != 256) fprintf(stderr, "kernel_launch: note: %d CUs\n", cus);
    }
    if (grid < 0) return;
    Args a{};
    for (int i = 0; i < 14; ++i) a.in[i] = (const float*)d_in[i];
    a.out = (float*)d_out; a.ws = (unsigned char*)d_ws;
#if MK_N_LAUNCHES == 1
    a.ph_lo = 0; a.ph_hi = 8;
    void* kargs[] = {&a};
    hipError_t e = hipLaunchCooperativeKernel((const void*)fwd_megakernel, dim3(grid), dim3(NTHREADS), kargs, LDS_BYTES, stream);
    if (e != hipSuccess) fprintf(stderr, "kernel_launch: cooperative launch failed: %s (grid %d)\n", hipGetErrorString(e), grid);
#else
    for (int p = 0; p < 8; ++p) { a.ph_lo = p; a.ph_hi = p + 1; hipLaunchKernelGGL(fwd_megakernel, dim3(grid), dim3(NTHREADS), LDS_BYTES, stream, a); }
#endif
}
```
